# Optimizing an MI355X kernel written in HIP

```python
import math
import jax, jax.numpy as jnp
from jax import lax
import numpy as np

D_MODEL = 1024
BATCH = 4
SEQ = 8192
DEPTH = 2
DEC_BATCH = 128
DEC_SEQ = 4
PAST_LEN = 16384
PAGE_SIZE = 128

HEAD_DIM = 64
MIX_WIDTH = D_MODEL
SSD_HEADS = 8
SSD_INNER = SSD_HEADS * HEAD_DIM
SSD_GROUPS = 2
SSD_STATE = 128
SSD_CONV = 4
SSD_CHUNK = 128
SSD_CONV_DIM = SSD_INNER + 2 * SSD_GROUPS * SSD_STATE
ATT_HEADS = 8
ATT_KV_HEADS = 2
ATT_GROUP = ATT_HEADS // ATT_KV_HEADS
ATT_WIDTH = ATT_HEADS * HEAD_DIM
KV_WIDTH = ATT_KV_HEADS * HEAD_DIM
WINDOW = 128
ATT_BLOCK = 128
D_FF = 2816
FFN_CONV = 3
SPLITS = [SSD_INNER,
          SSD_INNER + SSD_CONV_DIM,
          SSD_INNER + SSD_CONV_DIM + SSD_HEADS,
          SSD_INNER + SSD_CONV_DIM + SSD_HEADS + ATT_WIDTH,
          SSD_INNER + SSD_CONV_DIM + SSD_HEADS + ATT_WIDTH + KV_WIDTH]
IN_DIM = SSD_INNER + SSD_CONV_DIM + SSD_HEADS + ATT_WIDTH + 2 * KV_WIDTH
EPS = 1e-6

kernel_name = 'hybrid_ssd_swa_sink_convffn_step'


def rmsnorm(x, w):
    xf = x.astype(jnp.float32)
    y = xf * lax.rsqrt(jnp.mean(xf * xf, axis=-1, keepdims=True) + EPS)
    return (y * w.astype(jnp.float32)).astype(x.dtype)


def causal_dwconv(h, prev, w, b):
    k = w.shape[0]
    length = h.shape[1]
    hp = jnp.concatenate([prev, h], axis=1)
    out = hp[:, 0:length] * w[0]
    for i in range(1, k):
        out = out + hp[:, i:i + length] * w[i]
    return out + b, hp[:, length:]


def alibi_slopes():
    s = 2.0 ** (-8.0 * np.arange(1, ATT_HEADS + 1) / ATT_HEADS)
    return jnp.asarray(s.reshape(ATT_KV_HEADS, ATT_GROUP), dtype=jnp.float32)


def sink_probs(scores, rel, valid, slopes, sink):
    s = scores.astype(jnp.float32) - slopes[:, :, None, None] * rel.astype(jnp.float32)
    s = jnp.where(valid, s, -jnp.inf)
    sk = sink.astype(jnp.float32)[:, :, None, None]
    m = jnp.maximum(jnp.max(s, axis=-1, keepdims=True), sk)
    p = jnp.exp(s - m)
    return p / (jnp.sum(p, axis=-1, keepdims=True) + jnp.exp(sk - m))


def swa_prompt(q, k, v, slopes, sink):
    b, s = q.shape[:2]
    nq = ATT_BLOCK
    nb = s // nq
    qb = q.reshape(b, nb, nq, ATT_KV_HEADS, ATT_GROUP, HEAD_DIM)
    kb = k.reshape(b, nb, nq, ATT_KV_HEADS, HEAD_DIM)
    vb = v.reshape(b, nb, nq, ATT_KV_HEADS, HEAD_DIM)

    def with_prev(t):
        prev = jnp.concatenate([jnp.zeros_like(t[:, :1]), t[:, :-1]], axis=1)
        return jnp.concatenate([prev, t], axis=2)

    kk, vv = with_prev(kb), with_prev(vb)
    scores = jnp.einsum('bnqkgd,bnskd->bnkgqs', qb, kk) * (HEAD_DIM ** -0.5)
    qi = jnp.arange(nq)[:, None]
    sj = jnp.arange(2 * nq)[None, :]
    rel = qi + nq - sj
    key_pos = jnp.arange(nb)[:, None, None] * nq + sj[None] - nq
    valid = (rel >= 0) & (rel < WINDOW) & (key_pos >= 0)
    probs = sink_probs(scores, rel, valid[:, None, None], slopes, sink).astype(v.dtype)
    out = jnp.einsum('bnkgqs,bnskd->bnqkgd', probs, vv)
    return out.reshape(b, s, ATT_WIDTH)


def swa_sample(q, k, v, k_buf, v_buf, slopes, sink):
    b, t = q.shape[:2]
    w = k_buf.shape[1]
    kk = jnp.concatenate([k_buf, k], axis=1)
    vv = jnp.concatenate([v_buf, v], axis=1)
    qg = q.reshape(b, t, ATT_KV_HEADS, ATT_GROUP, HEAD_DIM)
    scores = jnp.einsum('btkgd,bskd->bkgts', qg, kk) * (HEAD_DIM ** -0.5)
    rel = jnp.arange(t)[:, None] + w - jnp.arange(w + t)[None, :]
    valid = (rel >= 0) & (rel < WINDOW)
    probs = sink_probs(scores, rel, valid, slopes, sink).astype(v.dtype)
    out = jnp.einsum('bkgts,bskd->btkgd', probs, vv).reshape(b, t, ATT_WIDTH)
    return out, kk[:, t:], vv[:, t:]


def ssd_scan(x, dt, a, bm, cm, h0, chunk):
    b, l, h, p = x.shape
    g, n = bm.shape[2:]
    r = h // g
    nc = l // chunk
    f32 = jnp.float32
    xc = x.reshape(b, nc, chunk, h, p)
    dtc = dt.reshape(b, nc, chunk, h)
    bc = bm.reshape(b, nc, chunk, g, n)
    cc = cm.reshape(b, nc, chunk, g, n)
    acum = jnp.cumsum(dtc * a, axis=2)
    acum_h = jnp.moveaxis(acum, 3, 2)
    seg = acum_h[..., :, None] - acum_h[..., None, :]
    causal = jnp.tril(jnp.ones((chunk, chunk), dtype=bool))
    decay = jnp.exp(jnp.where(causal, seg, -jnp.inf))
    cb = jnp.repeat(jnp.einsum('bclgn,bcsgn->bcgls', cc, bc), r, axis=2)
    xdt = xc * dtc[..., None].astype(x.dtype)
    y_diag = jnp.einsum('bchls,bcshp->bclhp', (cb * decay).astype(x.dtype), xdt)
    tail = jnp.exp(acum[:, :, -1:, :] - acum)
    bh = jnp.repeat(bc, r, axis=3)
    states = jnp.einsum('bclhn,bclhp->bchpn', bh * (tail * dtc)[..., None].astype(x.dtype), xc)
    chunk_decay = jnp.exp(acum[:, :, -1, :])

    def step(carry, inp):
        st, dc = inp
        return carry * dc[:, :, None, None] + st, carry

    final, prev = lax.scan(step, h0.astype(f32),
                           (jnp.moveaxis(states.astype(f32), 1, 0), jnp.moveaxis(chunk_decay, 1, 0)))
    prev = jnp.moveaxis(prev, 0, 1)
    ch = jnp.repeat(cc, r, axis=3)
    y_off = jnp.einsum('bclhn,bchpn->bclhp', ch.astype(f32), prev) * jnp.exp(acum)[..., None]
    y = (y_diag.astype(f32) + y_off).astype(x.dtype).reshape(b, l, h, p)
    return y, final.astype(h0.dtype)


def ssd_mixer(z, xbc, dt_raw, conv_prev, h0, lp):
    b, l = z.shape[:2]
    xbc, conv_new = causal_dwconv(xbc, conv_prev, lp['ssd_conv_w'], lp['ssd_conv_b'])
    xbc = jax.nn.silu(xbc)
    xs = xbc[..., :SSD_INNER].reshape(b, l, SSD_HEADS, HEAD_DIM)
    bm = xbc[..., SSD_INNER:SSD_INNER + SSD_GROUPS * SSD_STATE].reshape(b, l, SSD_GROUPS, SSD_STATE)
    cm = xbc[..., SSD_INNER + SSD_GROUPS * SSD_STATE:].reshape(b, l, SSD_GROUPS, SSD_STATE)
    dt = jax.nn.softplus((dt_raw + lp['dt_bias']).astype(jnp.float32))
    a = -jnp.exp(lp['a_log'].astype(jnp.float32))
    chunk = SSD_CHUNK if l % SSD_CHUNK == 0 else l
    y, h_new = ssd_scan(xs, dt, a, bm, cm, h0, chunk)
    y = y + xs * lp['d_skip'][:, None]
    y = y.reshape(b, l, SSD_INNER) * jax.nn.silu(z)
    gs = SSD_INNER // SSD_GROUPS
    y = rmsnorm(y.reshape(b, l, SSD_GROUPS, gs), lp['ssd_norm'].reshape(SSD_GROUPS, gs)).reshape(b, l, SSD_INNER)
    return y, conv_new, h_new


def hybrid_layer(x, lp, ssd_conv_prev, ssm_prev, ffn_conv_prev, kv_buf):
    b, l, _ = x.shape
    hn = rmsnorm(x, lp['norm1'])
    proj = hn @ lp['w_in']
    z, xbc, dt_raw, q, k, v = jnp.split(proj, SPLITS, axis=-1)
    y_ssd, ssd_conv_new, ssm_new = ssd_mixer(z, xbc, dt_raw, ssd_conv_prev, ssm_prev, lp)
    q = rmsnorm(q.reshape(b, l, ATT_HEADS, HEAD_DIM), lp['q_norm'])
    k = rmsnorm(k.reshape(b, l, ATT_KV_HEADS, HEAD_DIM), lp['k_norm'])
    v = v.reshape(b, l, ATT_KV_HEADS, HEAD_DIM)
    slopes = alibi_slopes()
    sink = lp['sinks'].reshape(ATT_KV_HEADS, ATT_GROUP)
    if kv_buf is None:
        y_att = swa_prompt(q, k, v, slopes, sink)
        k_new, v_new = k[:, -WINDOW:], v[:, -WINDOW:]
    else:
        y_att, k_new, v_new = swa_sample(q, k, v, kv_buf[0], kv_buf[1], slopes, sink)
    x = x + jnp.concatenate([y_ssd, y_att], axis=-1) @ lp['w_out']
    hn = rmsnorm(x, lp['norm2'])
    u, ffn_conv_new = causal_dwconv(hn @ lp['w_up'], ffn_conv_prev, lp['ffn_conv_w'], lp['ffn_conv_b'])
    gate, val = jnp.split(u, 2, axis=-1)
    x = x + (jax.nn.silu(gate) * val) @ lp['w_down']
    return x, (ssm_new, ssd_conv_new, k_new, v_new, ffn_conv_new)


def setup_inputs(seed: int = 0) -> dict:
    key = jax.random.key(seed)
    ks = iter(jax.random.split(key, 40))
    f32 = jnp.float32

    def nrm(shape, scale):
        return jax.random.normal(next(ks), shape, f32) * scale

    w_buf = min(WINDOW, PAST_LEN)
    dt0 = jnp.exp(jax.random.uniform(next(ks), (DEPTH, SSD_HEADS), f32, math.log(1e-3), math.log(1e-1)))
    return {
        'x_prompt': nrm((BATCH, SEQ, D_MODEL), 1.0),
        'x_sample': nrm((DEC_BATCH, DEC_SEQ, D_MODEL), 1.0),
        'state_ssm': nrm((DEPTH, DEC_BATCH, SSD_HEADS, HEAD_DIM, SSD_STATE), 0.1),
        'state_ssd_conv': nrm((DEPTH, DEC_BATCH, SSD_CONV - 1, SSD_CONV_DIM), 1.0),
        'cache_swa_k': nrm((DEPTH, DEC_BATCH, w_buf, ATT_KV_HEADS, HEAD_DIM), 1.0),
        'cache_swa_v': nrm((DEPTH, DEC_BATCH, w_buf, ATT_KV_HEADS, HEAD_DIM), 1.0),
        'state_ffn_conv': nrm((DEPTH, DEC_BATCH, FFN_CONV - 1, 2 * D_FF), 1.0),
        'norm1_w': 1.0 + nrm((DEPTH, D_MODEL), 0.01),
        'w_in': nrm((DEPTH, D_MODEL, IN_DIM), D_MODEL ** -0.5),
        'ssd_conv_w': nrm((DEPTH, SSD_CONV, SSD_CONV_DIM), SSD_CONV ** -0.5),
        'ssd_conv_b': nrm((DEPTH, SSD_CONV_DIM), 0.02),
        'dt_bias': dt0 + jnp.log(-jnp.expm1(-dt0)),
        'a_log': jnp.log(jax.random.uniform(next(ks), (DEPTH, SSD_HEADS), f32, 1.0, 16.0)),
        'd_skip': 1.0 + nrm((DEPTH, SSD_HEADS), 0.1),
        'ssd_norm_w': 1.0 + nrm((DEPTH, SSD_INNER), 0.01),
        'q_norm_w': 1.0 + nrm((DEPTH, HEAD_DIM), 0.01),
        'k_norm_w': 1.0 + nrm((DEPTH, HEAD_DIM), 0.01),
        'attn_sinks': nrm((DEPTH, ATT_HEADS), 0.5),
        'w_out': nrm((DEPTH, MIX_WIDTH, D_MODEL), MIX_WIDTH ** -0.5),
        'norm2_w': 1.0 + nrm((DEPTH, D_MODEL), 0.01),
        'w_up': nrm((DEPTH, D_MODEL, 2 * D_FF), D_MODEL ** -0.5),
        'ffn_conv_w': nrm((DEPTH, FFN_CONV, 2 * D_FF), FFN_CONV ** -0.5),
        'ffn_conv_b': nrm((DEPTH, 2 * D_FF), 0.02),
        'w_down': nrm((DEPTH, D_FF, D_MODEL), D_FF ** -0.5),
    }


def reference(x_prompt, x_sample, state_ssm, state_ssd_conv, cache_swa_k, cache_swa_v, state_ffn_conv,
              norm1_w, w_in, ssd_conv_w, ssd_conv_b, dt_bias, a_log, d_skip, ssd_norm_w,
              q_norm_w, k_norm_w, attn_sinks, w_out, norm2_w, w_up, ffn_conv_w, ffn_conv_b, w_down):
    def layer_params(i):
        return dict(norm1=norm1_w[i], w_in=w_in[i], ssd_conv_w=ssd_conv_w[i], ssd_conv_b=ssd_conv_b[i],
                    dt_bias=dt_bias[i], a_log=a_log[i], d_skip=d_skip[i], ssd_norm=ssd_norm_w[i],
                    q_norm=q_norm_w[i], k_norm=k_norm_w[i], sinks=attn_sinks[i], w_out=w_out[i],
                    norm2=norm2_w[i], w_up=w_up[i], ffn_conv_w=ffn_conv_w[i], ffn_conv_b=ffn_conv_b[i],
                    w_down=w_down[i])

    b = x_prompt.shape[0]
    dtype = x_prompt.dtype
    xp, xs = x_prompt, x_sample
    p_states, s_states = [], []
    for i in range(DEPTH):
        lp = layer_params(i)
        xp, st_p = hybrid_layer(xp, lp,
                                jnp.zeros((b, SSD_CONV - 1, SSD_CONV_DIM), dtype),
                                jnp.zeros((b, SSD_HEADS, HEAD_DIM, SSD_STATE), dtype),
                                jnp.zeros((b, FFN_CONV - 1, 2 * D_FF), dtype),
                                None)
        xs, st_s = hybrid_layer(xs, lp, state_ssd_conv[i], state_ssm[i], state_ffn_conv[i],
                                (cache_swa_k[i], cache_swa_v[i]))
        p_states.append(st_p)
        s_states.append(st_s)

    def stacked(states, j):
        return jnp.stack([st[j] for st in states])

    return (xp, xs,
            stacked(p_states, 0), stacked(p_states, 1), stacked(p_states, 2), stacked(p_states, 3), stacked(p_states, 4),
            stacked(s_states, 0), stacked(s_states, 1), stacked(s_states, 2), stacked(s_states, 3), stacked(s_states, 4))
```

```cpp
#include <hip/hip_runtime.h>
#include <hip/hip_cooperative_groups.h>
#include <cstdio>
#include <cstdint>
namespace cg = cooperative_groups;

#define LAS __attribute__((address_space(3)))
typedef unsigned short bf16_t;
typedef short bf16x8 __attribute__((ext_vector_type(8)));
typedef short bf16x4 __attribute__((ext_vector_type(4)));
typedef float f32x4 __attribute__((ext_vector_type(4)));
typedef float f32x2 __attribute__((ext_vector_type(2)));
typedef unsigned u32x4 __attribute__((ext_vector_type(4)));
typedef unsigned u32x2 __attribute__((ext_vector_type(2)));

#ifndef MK_MULTI
#define MK_MULTI 1
#endif

constexpr int MP = 32768, MS = 512, MT = MP + MS;
constexpr int DM = 1024, NPROJ = 2304, DFF = 2816, NUP = 5632, IN_DIM = 2312;
constexpr int PC_Z = 0, PC_XBC = 512, PC_Q = 1536, PC_K = 2048, PC_V = 2176;
constexpr float EPS = 1e-6f;
constexpr size_t O_Y = 0, O_PSSM = 34078720, O_PCONV = 34603008, O_PK = 34627584, O_PV = 34758656, O_PFFN = 34889728,
                 O_SSSM = 34979840, O_SCONV = 51757056, O_SK = 52543488, O_SV = 56737792, O_SFFN = 60932096;
constexpr size_t MiB = 1u << 20;
constexpr size_t WS_CTL = 0, WS_WIN = 1 * MiB, WS_WOUT = 10 * MiB, WS_WUP = 14 * MiB, WS_WDN = 36 * MiB, WS_HN = 47 * MiB,
                 WS_DT = 112 * MiB, WS_AC = 114 * MiB, WS_CD = 116 * MiB, WS_YCAT = 117 * MiB, WS_PROJ = 182 * MiB,
                 WS_XTG = 329 * MiB, WS_BCN = 361 * MiB, WS_ST = 394 * MiB, WS_G = 182 * MiB, WS_UH = 361 * MiB, WS_END = 458 * MiB;
constexpr size_t WIN_L = (size_t)NPROJ * DM * 2, WOUT_L = (size_t)DM * DM * 2, WUP_L = (size_t)NUP * DM * 2, WDN_L = (size_t)DM * DFF * 2;
constexpr int LDS_BYTES = 155648;

__device__ __forceinline__ float bf2f(unsigned b) { return __uint_as_float(b << 16); }
__device__ __forceinline__ unsigned pk2(float lo, float hi) { unsigned r; asm volatile("v_cvt_pk_bf16_f32 %0, %1, %2" : "=v"(r) : "v"(lo), "v"(hi)); return r; }
__device__ __forceinline__ float silu_f(float x) { return x / (1.f + __expf(-x)); }
__device__ __forceinline__ float wave_sum(float v) {
#pragma unroll
    for (int o = 1; o < 64; o <<= 1) v += __shfl_xor(v, o);
    return v;
}
template <int CTRL> __device__ __forceinline__ float dpp0(float x) {
    return __builtin_bit_cast(float, __builtin_amdgcn_update_dpp(0, __builtin_bit_cast(int, x), CTRL, 0xf, 0xf, true));
}
#define DPP_SHR1 0x111
#define DPP_SHR2 0x112
#define DPP_SHL14 0x10E
#define DPP_SHL15 0x10F
__device__ __forceinline__ bf16x8 cvt8(const f32x4 a, const f32x4 b) {
    u32x4 w; w.x = pk2(a[0], a[1]); w.y = pk2(a[2], a[3]); w.z = pk2(b[0], b[1]); w.w = pk2(b[2], b[3]);
    return __builtin_bit_cast(bf16x8, w);
}
__device__ __forceinline__ int opaque_tid() { int t = threadIdx.x; asm volatile("" : "+v"(t)); return t; }
namespace pg8 {
#define PG8_LAS __attribute__((address_space(3)))
typedef unsigned short bf16_t;
typedef short bf16x8 __attribute__((ext_vector_type(8)));
typedef float f32x4 __attribute__((ext_vector_type(4)));
typedef unsigned u32x4 __attribute__((ext_vector_type(4)));
constexpr int BM = 256, BK = 64, HALF = 128, HTB = HALF * BK * 2  , STAGE_BYTES = 8 * HTB, NXCD = 8, WGM = 8;

__host__ __device__ __forceinline__ int lds_byte(int r, int c) { const int st = (r >> 4) * 2 + (c >> 5), rr = r & 15, cc = c & 31, ob = rr * 64 + cc * 2; return st * 1024 + (ob ^ (((ob >> 9) & 1) << 5)); }
__host__ __device__ __forceinline__ void stage_rc(int b, int& R, int& C) { const int st = b / 1024, sb = b % 1024, swz = sb ^ (((sb >> 9) & 1) << 5); R = (st >> 1) * 16 + swz / 64; C = (st & 1) * 32 + (swz % 64) / 2; }
__host__ __device__ __forceinline__ int perm32(int rho) { const int n = rho >> 4, i = rho & 15; return 8 * (i >> 2) + 4 * n + (i & 3); }

struct Unit { int pm, pn; };
struct Gemm { const bf16_t* A; const bf16_t* Bt; int M, N, K; };

struct StaticOrder {
    int nM, nN, nwg, G, c;
    __host__ __device__ void init(int M, int N, int G_, int c_) { nM = M / BM; nN = N / BM; nwg = nM * nN; G = G_; c = c_; }
    __host__ __device__ bool next(int i, Unit& u) const {
        const long L = (long)i * G + c; if (L >= nwg) return false;
        int wgid = (int)L; { const int q = nwg / NXCD, r = nwg % NXCD, xcd = wgid % NXCD, off = wgid / NXCD; wgid = (xcd < r ? xcd * (q + 1) : r * (q + 1) + (xcd - r) * q) + off; }
        const int nig = WGM * nN, gid = wgid / nig, fm = gid * WGM, gsz = (nM - fm) < WGM ? (nM - fm) : WGM;
        u.pm = fm + ((wgid % nig) % gsz); u.pn = (wgid % nig) / gsz; return true;
    }
    __device__ __forceinline__ void a_ready(const Unit&) const {}
    __device__ __forceinline__ void done(const Unit&) const {}
};
struct EpiProj {
    static constexpr bool PERM = true, AFTER_DRAIN = false;
    bf16_t* O; int ldc;
    __device__ __forceinline__ void operator()(const f32x4 (&acc)[2][2][4][2], const Unit& u, int wr, int wc, int fr, int fq) const {
        const int row0 = u.pm * BM + wr * 64 + fr, col0 = u.pn * BM + wc * 32 + 8 * fq;
#pragma unroll
        for (int ai = 0; ai < 2; ++ai)
#pragma unroll
            for (int m = 0; m < 4; ++m) { bf16_t* rowp = O + (size_t)(row0 + ai * HALF + m * 16) * ldc + col0;
#pragma unroll
                for (int bj = 0; bj < 2; ++bj) { const f32x4 v0 = acc[ai][bj][m][0], v1 = acc[ai][bj][m][1];
                    u32x4 w; w.x = pk2(v0[0], v0[1]); w.y = pk2(v0[2], v0[3]); w.z = pk2(v1[0], v1[1]); w.w = pk2(v1[2], v1[3]);
                    *(u32x4*)(rowp + bj * HALF) = w; } }
    }
};
struct EpiResid {
    static constexpr bool PERM = false, AFTER_DRAIN = false;
    const float* resP; const float* resS; float* out;
    __device__ __forceinline__ void operator()(const f32x4 (&acc)[2][2][4][2], const Unit& u, int wr, int wc, int fr, int fq) const {
        const int row0 = u.pm * BM + wr * 64 + fr, col0 = u.pn * BM + wc * 32 + 4 * fq;
#pragma unroll
        for (int ai = 0; ai < 2; ++ai)
#pragma unroll
            for (int m = 0; m < 4; ++m) { const int row = row0 + ai * HALF + m * 16;
                const float* rp = (row < MP) ? resP + (size_t)row * DM : resS + (size_t)(row - MP) * DM; float* op = out + (size_t)row * DM;
#pragma unroll
                for (int bj = 0; bj < 2; ++bj)
#pragma unroll
                    for (int n = 0; n < 2; ++n) { const int c = col0 + bj * HALF + n * 16; *(f32x4*)(op + c) = *(const f32x4*)(rp + c) + acc[ai][bj][m][n]; } }
    }
};
struct EpiUp {
    static constexpr bool PERM = true, AFTER_DRAIN = false;
    bf16_t* G; float* UH; const float* cw; const float* cb; const float* sprev; float* snew;
    __device__ __forceinline__ void operator()(const f32x4 (&acc)[2][2][4][2], const Unit& u, int wr, int wc, int fr, int fq) const {
        const int jbase = u.pn * 128 + wc * 32 + 8 * fq;
        const bool sample = u.pm >= 128;
#pragma unroll
        for (int ai = 0; ai < 2; ++ai) {
            const int rowg = u.pm * BM + ai * HALF + wr * 64;
#pragma unroll
            for (int n = 0; n < 2; ++n) {
                const int j = jbase + 4 * n;
                const f32x4 w0g = *(const f32x4*)(cw + j), w1g = *(const f32x4*)(cw + NUP + j), w2g = *(const f32x4*)(cw + 2 * NUP + j), bg = *(const f32x4*)(cb + j);
                const f32x4 w0v = *(const f32x4*)(cw + DFF + j), w1v = *(const f32x4*)(cw + NUP + DFF + j), w2v = *(const f32x4*)(cw + 2 * NUP + DFF + j), bv = *(const f32x4*)(cb + DFF + j);
#pragma unroll
                for (int m = 0; m < 4; ++m) {
                    __builtin_amdgcn_sched_barrier(0);
                    const f32x4 vg = acc[ai][0][m][n], vv = acc[ai][1][m][n];
                    f32x4 p1g, p2g, p1v, p2v;
#pragma unroll
                    for (int i = 0; i < 4; ++i) {
                        p1g[i] = dpp0<DPP_SHR1>(vg[i]); p2g[i] = dpp0<DPP_SHR2>(vg[i]); p1v[i] = dpp0<DPP_SHR1>(vv[i]); p2v[i] = dpp0<DPP_SHR2>(vv[i]);
                        if (m > 0) { const float og = acc[ai][0][m > 0 ? m - 1 : 0][n][i], ov = acc[ai][1][m > 0 ? m - 1 : 0][n][i];
                            p1g[i] += dpp0<DPP_SHL15>(og); p2g[i] += dpp0<DPP_SHL14>(og); p1v[i] += dpp0<DPP_SHL15>(ov); p2v[i] += dpp0<DPP_SHL14>(ov); }
                    }
                    const int r = rowg + 16 * m + fr;
                    if (sample) {
                        const int sr = r - MP, b = sr >> 2, t = sr & 3;
                        if (t < 2) {
                            const float* s1p = sprev + (size_t)(b * 2 + 1) * NUP + j; const float* s0p = sprev + (size_t)(b * 2) * NUP + j;
                            const f32x4 s1g = *(const f32x4*)s1p, s1v = *(const f32x4*)(s1p + DFF);
                            if (t == 0) { p2g = *(const f32x4*)s0p; p2v = *(const f32x4*)(s0p + DFF); p1g = s1g; p1v = s1v; }
                            else { p2g = s1g; p2v = s1v; }
                        } else {
                            float* np = snew + (size_t)(b * 2 + (t - 2)) * NUP + j; *(f32x4*)np = vg; *(f32x4*)(np + DFF) = vv;
                        }
                    } else {
                        int slot = -1;
                        if (m == 0 && fr < 2) slot = fr; else if (m == 3 && fr >= 14) slot = fr - 12;
                        if (slot >= 0) { float* up = UH + ((size_t)(r >> 6) * 4 + slot) * NUP + j; *(f32x4*)up = vg; *(f32x4*)(up + DFF) = vv; }
                    }
                    const f32x4 cg_ = w0g * p2g + w1g * p1g + w2g * vg + bg, cv_ = w0v * p2v + w1v * p1v + w2v * vv + bv;
                    float g0 = silu_f(cg_[0]) * cv_[0], g1 = silu_f(cg_[1]) * cv_[1], g2 = silu_f(cg_[2]) * cv_[2], g3 = silu_f(cg_[3]) * cv_[3];
                    if (sample || !(m == 0 && fr < 2)) { u32x2 w; w.x = pk2(g0, g1); w.y = pk2(g2, g3); *(u32x2*)(G + (size_t)r * DFF + j) = w; }
                }
            }
        }
    }
};
template <class Epi, class Sched, bool STAMP = false>
__device__ __forceinline__ void gemm_phase(PG8_LAS unsigned char* lds, const Gemm g, const Sched& S, const Epi& E, unsigned long long* stamps) {
    const int tid = opaque_tid(), wid = __builtin_amdgcn_readfirstlane(tid >> 6), lane = tid & 63, wr = wid >> 2, wc = wid & 3, fr = lane & 15, fq = lane >> 4;
    const int K = g.K, nt = K / BK;
    int ts_lo = 0, ts_hi = 0, nts = 0; const unsigned long long rt_entry = STAMP ? (unsigned long long)wall_clock64() : 0ull;
#define PG8_STAMP() do { if (STAMP && wid == 0 && nts < 64) { const unsigned long long _c = (unsigned long long)clock64(); \
        ts_lo = (lane == nts) ? (int)(unsigned)_c : ts_lo; ts_hi = (lane == nts) ? (int)(unsigned)(_c >> 32) : ts_hi; ++nts; } } while (0)
    PG8_STAMP();
    unsigned voffA[2], voffB[2];
#pragma unroll
    for (int i = 0; i < 2; ++i) { int R, C; stage_rc(tid * 16 + i * 8192, R, C); const int Rb = Epi::PERM ? ((R & ~31) + perm32(R & 31)) : R;
        voffA[i] = (unsigned)(R * K + C) * 2u; voffB[i] = (unsigned)(Rb * K + C) * 2u; }
    const size_t kstep = (size_t)(BK * 2);
    const size_t hstep = (size_t)HALF * K * 2;
    const size_t tstep = 2 * hstep;
    const unsigned ldsw = (unsigned)wid * 1024u;
    const int aoff = lds_byte(wr * 64 + fr, fq * 8), boff = lds_byte(wc * 32 + fr, fq * 8);
#define PG8_SA(b, h) (((b) * 2 + (h)) * HTB)
#define PG8_SB(b, h) ((4 + (b) * 2 + (h)) * HTB)
#define PG8_STAGE(bufoff, gbase, voff) do { _Pragma("unroll") for (int _i = 0; _i < 2; ++_i) \
        __builtin_amdgcn_global_load_lds((const unsigned*)((const char*)(gbase) + (voff)[_i]), (PG8_LAS unsigned*)(lds + (bufoff) + ldsw + _i * 8192), 16, 0, 0); } while (0)
#define PG8_LDA(dst, b, h) do { _Pragma("unroll") for (int m = 0; m < 4; ++m) _Pragma("unroll") for (int k = 0; k < 2; ++k) dst[m][k] = *(const PG8_LAS bf16x8*)(lds + PG8_SA(b, h) + aoff + m * 2048 + k * 1024); } while (0)
#define PG8_LDB(dst, b, h) do { _Pragma("unroll") for (int n = 0; n < 2; ++n) _Pragma("unroll") for (int k = 0; k < 2; ++k) dst[n][k] = *(const PG8_LAS bf16x8*)(lds + PG8_SB(b, h) + boff + n * 2048 + k * 1024); } while (0)
#define PG8_MMA(ai, bj, At, Bt) do { __builtin_amdgcn_s_setprio(1); _Pragma("unroll") for (int m = 0; m < 4; ++m) _Pragma("unroll") for (int n = 0; n < 2; ++n) _Pragma("unroll") for (int k = 0; k < 2; ++k) \
        acc[ai][bj][m][n] = __builtin_amdgcn_mfma_f32_16x16x32_bf16(Bt[n][k], At[m][k], acc[ai][bj][m][n], 0, 0, 0); __builtin_amdgcn_s_setprio(0); } while (0)
#define PG8_WAIT_V(n) asm volatile("s_waitcnt vmcnt(" #n ")" ::: "memory")
#define PG8_WAIT_L(n) asm volatile("s_waitcnt lgkmcnt(" #n ")" ::: "memory")
#define PG8_BAR __builtin_amdgcn_s_barrier()
#define PG8_SCHED __builtin_amdgcn_sched_barrier(0)
    Unit cur, nxt; int ui = 0;
    if (!S.next(0, cur)) return;
    f32x4 acc[2][2][4][2];
#pragma unroll
    for (int a = 0; a < 2; ++a)
#pragma unroll
        for (int b = 0; b < 2; ++b)
#pragma unroll
            for (int m = 0; m < 4; ++m)
#pragma unroll
                for (int n = 0; n < 2; ++n) acc[a][b][m][n] = (f32x4){0.f, 0.f, 0.f, 0.f};
    bf16x8 At[4][2], B0[2][2], B1[2][2];
    const char* cA = (const char*)g.A + (size_t)cur.pm * tstep; const char* cB = (const char*)g.Bt + (size_t)cur.pn * tstep;
    S.a_ready(cur);
    PG8_STAGE(PG8_SB(0, 0), cB, voffB); PG8_STAGE(PG8_SA(0, 0), cA, voffA); PG8_STAGE(PG8_SB(0, 1), cB + hstep, voffB); PG8_STAGE(PG8_SA(0, 1), cA + hstep, voffA);
    if (wr == 1) PG8_BAR;
    PG8_WAIT_V(4); PG8_BAR;
    PG8_STAGE(PG8_SB(1, 0), cB + kstep, voffB); PG8_STAGE(PG8_SA(1, 0), cA + kstep, voffA); PG8_STAGE(PG8_SB(1, 1), cB + hstep + kstep, voffB);
    PG8_WAIT_V(6); PG8_BAR;
    PG8_STAMP();
    for (;;) {
        const bool has_next = S.next(ui + 1, nxt);
        const char* nA = has_next ? (const char*)g.A + (size_t)nxt.pm * tstep : cA; const char* nB = has_next ? (const char*)g.Bt + (size_t)nxt.pn * tstep : cB;
        for (int t = 0; t < nt; t += 2) {
            const bool last = (t == nt - 2);
            const char* a1 = cA + (size_t)(t + 1) * kstep;
            const char* a2 = last ? nA : cA + (size_t)(t + 2) * kstep; const char* b2 = last ? nB : cB + (size_t)(t + 2) * kstep;
            const char* a3 = a2 + kstep; const char* b3 = b2 + kstep;
            if (last && has_next) S.a_ready(nxt);
            PG8_LDB(B0, 0, 0); PG8_SCHED; PG8_LDA(At, 0, 0); PG8_STAGE(PG8_SA(1, 1), a1 + hstep, voffA);
            PG8_WAIT_L(8); PG8_BAR; PG8_WAIT_L(0); PG8_MMA(0, 0, At, B0); PG8_BAR; PG8_SCHED;
            PG8_LDB(B1, 0, 1); PG8_STAGE(PG8_SB(0, 0), b2, voffB);
            PG8_BAR; PG8_WAIT_L(0); PG8_MMA(0, 1, At, B1); PG8_BAR;
            PG8_LDA(At, 0, 1); PG8_STAGE(PG8_SA(0, 0), a2, voffA);
            PG8_BAR; PG8_WAIT_L(0); PG8_MMA(1, 0, At, B0); PG8_BAR; PG8_SCHED;
            PG8_STAGE(PG8_SB(0, 1), b2 + hstep, voffB);
            PG8_WAIT_V(6); PG8_BAR; PG8_MMA(1, 1, At, B1); PG8_BAR;
            PG8_LDB(B0, 1, 0); PG8_SCHED; PG8_LDA(At, 1, 0); PG8_STAGE(PG8_SA(0, 1), a2 + hstep, voffA);
            PG8_WAIT_L(8); PG8_BAR; PG8_WAIT_L(0); PG8_MMA(0, 0, At, B0); PG8_BAR; PG8_SCHED;
            PG8_LDB(B1, 1, 1); PG8_STAGE(PG8_SB(1, 0), b3, voffB);
            PG8_BAR; PG8_WAIT_L(0); PG8_MMA(0, 1, At, B1); PG8_BAR;
            PG8_LDA(At, 1, 1); PG8_STAGE(PG8_SA(1, 0), a3, voffA);
            PG8_BAR; PG8_WAIT_L(0); PG8_MMA(1, 0, At, B0); PG8_BAR; PG8_SCHED;
            PG8_STAGE(PG8_SB(1, 1), b3 + hstep, voffB);
            PG8_WAIT_V(6); PG8_BAR; PG8_MMA(1, 1, At, B1); PG8_BAR;
        }
        PG8_STAMP();
        if constexpr (!Epi::AFTER_DRAIN) { E(acc, cur, wr, wc, fr, fq); S.done(cur); }
        PG8_STAMP();
        if (!has_next) break;
#pragma unroll
        for (int a = 0; a < 2; ++a)
#pragma unroll
            for (int b = 0; b < 2; ++b)
#pragma unroll
                for (int m = 0; m < 4; ++m)
#pragma unroll
                    for (int n = 0; n < 2; ++n) acc[a][b][m][n] = (f32x4){0.f, 0.f, 0.f, 0.f};
        cur = nxt; cA = nA; cB = nB; ++ui;
    }
    PG8_WAIT_V(0);
    if (wr == 0) PG8_BAR;
    PG8_BAR;
    if constexpr (Epi::AFTER_DRAIN) { E.fused(acc, cur, wr, wc, fr, fq, lds, wid, lane); S.done(cur); }
    PG8_STAMP();
    if (STAMP && wid == 0) { stamps[lane] = lane < nts ? (((unsigned long long)(unsigned)ts_hi << 32) | (unsigned)ts_lo) : 0ull;
        if (lane == 62) stamps[62] = rt_entry; if (lane == 63) stamps[63] = (unsigned long long)wall_clock64(); }
#undef PG8_STAMP
#undef PG8_SA
#undef PG8_SB
#undef PG8_STAGE
#undef PG8_LDA
#undef PG8_LDB
#undef PG8_MMA
#undef PG8_WAIT_V
#undef PG8_WAIT_L
#undef PG8_BAR
#undef PG8_SCHED
}
}

struct Params { const float* in[24]; float* out; unsigned char* ws; int ph_lo, ph_hi; };
enum { I_XP = 0, I_XS, I_SSM, I_SCONV, I_CK, I_CV, I_SFFN, I_N1, I_WIN, I_CW, I_CB, I_DTB, I_ALOG, I_DSKIP, I_SNORM, I_QN, I_KN, I_SINK, I_WOUT, I_N2, I_WUP, I_FCW, I_FCB, I_WDN };

__device__ __forceinline__ void transpose_item(const float* W, int K, int N, int srccol0, bf16_t* WT, int dstrow0, int k0, LAS float* scr, int lane) {
#pragma unroll 8
    for (int i = 0; i < 32; ++i) { const int kk = 2 * i + (lane >> 5); scr[kk * 33 + (lane & 31)] = W[(size_t)(k0 + kk) * N + srccol0 + (lane & 31)]; }
    asm volatile("s_waitcnt lgkmcnt(0)" ::: "memory");
    const int c = lane & 7;
#pragma unroll
    for (int j = 0; j < 4; ++j) { const int n = (lane >> 3) + 8 * j; const LAS float* s = scr + (8 * c) * 33 + n;
        u32x4 o; o.x = pk2(s[0 * 33], s[1 * 33]); o.y = pk2(s[2 * 33], s[3 * 33]); o.z = pk2(s[4 * 33], s[5 * 33]); o.w = pk2(s[6 * 33], s[7 * 33]);
        *(u32x4*)(WT + (size_t)(dstrow0 + n) * K + k0 + 8 * c) = o; }
    asm volatile("s_waitcnt lgkmcnt(0)" ::: "memory");
}
__device__ __forceinline__ void phase_weights(const Params& P, LAS unsigned char* lds) {
    const int tid = opaque_tid(), lane = tid & 63, wave = tid >> 6;
    LAS float* scr = (LAS float*)(lds + wave * 16384);
    const int gw = blockIdx.x * 8 + wave, NGW = gridDim.x * 8;
    constexpr int I_A = 16 * 72, I_B = 16 * 32, I_C = 16 * 176, I_D = 44 * 32, PER = I_A + I_B + I_C + I_D;
    for (int it = gw; it < 2 * PER; it += NGW) {
        const int l = it / PER; int r = it % PER;
        if (r < I_A) { const int kb = r / 72, nb = r % 72, n0 = 32 * nb;
            transpose_item(P.in[I_WIN] + (size_t)l * DM * IN_DIM, DM, IN_DIM, n0 + (n0 >= 1536 ? 8 : 0), (bf16_t*)(P.ws + WS_WIN + l * WIN_L), n0, 64 * kb, scr, lane); continue; }
        r -= I_A;
        if (r < I_B) { const int kb = r / 32, nb = r % 32;
            transpose_item(P.in[I_WOUT] + (size_t)l * DM * DM, DM, DM, 32 * nb, (bf16_t*)(P.ws + WS_WOUT + l * WOUT_L), 32 * nb, 64 * kb, scr, lane); continue; }
        r -= I_B;
        if (r < I_C) { const int kb = r / 176, nb = r % 176, n0 = 32 * nb, pn = n0 >> 8, rem = n0 & 255, bj = rem >> 7, cc = rem & 127;
            transpose_item(P.in[I_WUP] + (size_t)l * DM * NUP, DM, NUP, bj * DFF + pn * 128 + cc, (bf16_t*)(P.ws + WS_WUP + l * WUP_L), n0, 64 * kb, scr, lane); continue; }
        r -= I_C;
        { const int kb = r / 32, nb = r % 32;
            transpose_item(P.in[I_WDN] + (size_t)l * DFF * DM, DFF, DM, 32 * nb, (bf16_t*)(P.ws + WS_WDN + l * WDN_L), 32 * nb, 64 * kb, scr, lane); }
    }
}

template <bool WITH_DT>
__device__ __forceinline__ void phase_norm(const Params& P, LAS unsigned char* lds, int l, const float* xP, const float* xS, const float* nw) {
    const int tid = opaque_tid(), lane = tid & 63, wave = tid >> 6;
    bf16_t* HN = (bf16_t*)(P.ws + WS_HN);
    LAS float* WD = (LAS float*)lds;
    if (WITH_DT) {
        const float* win = P.in[I_WIN] + (size_t)l * DM * IN_DIM + 1536;
        for (int e = tid; e < DM * 8; e += 512) WD[e] = win[(size_t)(e >> 3) * IN_DIM + (e & 7)];
        __syncthreads();
    }
    f32x4 wv[4];
#pragma unroll
    for (int j = 0; j < 4; ++j) wv[j] = *(const f32x4*)(nw + 4 * lane + 256 * j);
    const int gw = blockIdx.x * 8 + wave, NGW = gridDim.x * 8;
    for (int row = gw; row < MT; row += NGW) {
        const float* xr = (row < MP) ? xP + (size_t)row * DM : xS + (size_t)(row - MP) * DM;
        f32x4 v[4]; float s = 0.f;
#pragma unroll
        for (int j = 0; j < 4; ++j) { v[j] = *(const f32x4*)(xr + 4 * lane + 256 * j); s += (v[j][0] * v[j][0] + v[j][1] * v[j][1]) + (v[j][2] * v[j][2] + v[j][3] * v[j][3]); }
        const float rstd = rsqrtf(wave_sum(s) * (1.f / DM) + EPS);
#pragma unroll
        for (int j = 0; j < 4; ++j) { v[j] = v[j] * rstd * wv[j];
            u32x2 o; o.x = pk2(v[j][0], v[j][1]); o.y = pk2(v[j][2], v[j][3]);
            *(u32x2*)(HN + (size_t)row * DM + 4 * lane + 256 * j) = o; }
        if (WITH_DT) {
            float d[8];
#pragma unroll
            for (int h = 0; h < 8; ++h) d[h] = 0.f;
#pragma unroll
            for (int j = 0; j < 4; ++j)
#pragma unroll
                for (int i = 0; i < 4; ++i) { const int k = 4 * lane + 256 * j + i; const f32x4 a = *(const LAS f32x4*)(WD + k * 8), b = *(const LAS f32x4*)(WD + k * 8 + 4); const float x = v[j][i];
                    d[0] += x * a[0]; d[1] += x * a[1]; d[2] += x * a[2]; d[3] += x * a[3]; d[4] += x * b[0]; d[5] += x * b[1]; d[6] += x * b[2]; d[7] += x * b[3]; }
#pragma unroll
            for (int h = 0; h < 8; ++h) d[h] = wave_sum(d[h]);
            if (lane < 8) { float dv = d[0];
#pragma unroll
                for (int h = 1; h < 8; ++h) dv = (lane == h) ? d[h] : dv;
                dv += P.in[I_DTB][l * 8 + lane];
                const float sp = fmaxf(dv, 0.f) + log1pf(__expf(-fabsf(dv)));
                ((float*)(P.ws + WS_DT))[(size_t)row * 8 + lane] = sp; }
        }
    }
}

__device__ __forceinline__ void attn_tile(const bf16_t* qp, const float* qw, const LAS bf16_t* Ks, const LAS bf16_t* VT, int jj0, int relbase, int kmin, int kmax,
                                          float slope, float sink, bf16_t* out, int r, int q) {
    bf16x8 qf[2];
    {
        const u32x4 a = *(const u32x4*)(qp + 8 * q), b = *(const u32x4*)(qp + 32 + 8 * q);
        float x[16];
#pragma unroll
        for (int i = 0; i < 4; ++i) { x[2 * i] = bf2f(a[i] & 0xffffu); x[2 * i + 1] = bf2f(a[i] >> 16); x[8 + 2 * i] = bf2f(b[i] & 0xffffu); x[8 + 2 * i + 1] = bf2f(b[i] >> 16); }
        float ss = 0.f;
#pragma unroll
        for (int i = 0; i < 16; ++i) ss += x[i] * x[i];
        ss += __shfl_xor(ss, 16); ss += __shfl_xor(ss, 32);
        const float sc = rsqrtf(ss * (1.f / 64.f) + EPS) * 0.125f;
        const f32x4 w0 = *(const f32x4*)(qw + 8 * q), w1 = *(const f32x4*)(qw + 8 * q + 4), w2 = *(const f32x4*)(qw + 32 + 8 * q), w3 = *(const f32x4*)(qw + 36 + 8 * q);
        const f32x4 a0 = {x[0] * sc * w0[0], x[1] * sc * w0[1], x[2] * sc * w0[2], x[3] * sc * w0[3]}, a1 = {x[4] * sc * w1[0], x[5] * sc * w1[1], x[6] * sc * w1[2], x[7] * sc * w1[3]};
        const f32x4 b0 = {x[8] * sc * w2[0], x[9] * sc * w2[1], x[10] * sc * w2[2], x[11] * sc * w2[3]}, b1 = {x[12] * sc * w3[0], x[13] * sc * w3[1], x[14] * sc * w3[2], x[15] * sc * w3[3]};
        qf[0] = cvt8(a0, a1); qf[1] = cvt8(b0, b1);
    }
    f32x4 s[9];
#pragma unroll
    for (int kt = 0; kt < 9; ++kt) {
        if ((kt & 1) == 0) __builtin_amdgcn_sched_barrier(0);
        s[kt] = (f32x4){0.f, 0.f, 0.f, 0.f};
#pragma unroll
        for (int ks = 0; ks < 2; ++ks) { const bf16x8 kf = *(const LAS bf16x8*)(Ks + (jj0 + 16 * kt + r) * 72 + 32 * ks + 8 * q);
            s[kt] = __builtin_amdgcn_mfma_f32_16x16x32_bf16(kf, qf[ks], s[kt], 0, 0, 0); }
    }
    __builtin_amdgcn_sched_barrier(0);
    float mx = sink;
#pragma unroll
    for (int kt = 0; kt < 9; ++kt)
#pragma unroll
        for (int j = 0; j < 4; ++j) { const int kl = 16 * kt + 4 * q + j, rel = relbase - kl; const bool valid = (rel >= 0) && (rel < 128) && (kl >= kmin) && (kl < kmax);
            const float v = valid ? s[kt][j] - slope * (float)rel : -1e30f; s[kt][j] = v; mx = fmaxf(mx, v); }
    mx = fmaxf(mx, __shfl_xor(mx, 16)); mx = fmaxf(mx, __shfl_xor(mx, 32));
    float den = 0.f;
#pragma unroll
    for (int kt = 0; kt < 9; ++kt)
#pragma unroll
        for (int j = 0; j < 4; ++j) { const float p = (s[kt][j] > -1e29f) ? __expf(s[kt][j] - mx) : 0.f; s[kt][j] = p; den += p; }
    den += __shfl_xor(den, 16); den += __shfl_xor(den, 32);
    den += __expf(sink - mx);
    const float inv = 1.f / den;
    __builtin_amdgcn_sched_barrier(0);
    f32x4 o[4];
#pragma unroll
    for (int dt = 0; dt < 4; ++dt) o[dt] = (f32x4){0.f, 0.f, 0.f, 0.f};
#pragma unroll
    for (int kk = 0; kk < 5; ++kk) {
        __builtin_amdgcn_sched_barrier(0);
        const f32x4 z4 = {0.f, 0.f, 0.f, 0.f};
        const bf16x8 pf = cvt8(s[2 * kk], (2 * kk + 1 < 9) ? s[2 * kk + 1 < 9 ? 2 * kk + 1 : 8] : z4);
#pragma unroll
        for (int dt = 0; dt < 4; ++dt) {
            const LAS bf16_t* vp = VT + (16 * dt + r) * 264 + jj0 + 32 * kk + 4 * q;
            const u32x2 lo = *(const LAS u32x2*)vp; u32x2 hi = {0u, 0u};
            if (2 * kk + 1 < 9) hi = *(const LAS u32x2*)(vp + 16);
            u32x4 w; w.x = lo.x; w.y = lo.y; w.z = hi.x; w.w = hi.y;
            o[dt] = __builtin_amdgcn_mfma_f32_16x16x32_bf16(__builtin_bit_cast(bf16x8, w), pf, o[dt], 0, 0, 0);
        }
    }
#pragma unroll
    for (int dt = 0; dt < 4; ++dt) { u32x2 w; w.x = pk2(o[dt][0] * inv, o[dt][1] * inv); w.y = pk2(o[dt][2] * inv, o[dt][3] * inv); *(u32x2*)(out + 16 * dt + 4 * q) = w; }
}

__device__ __forceinline__ void ssd_prep_unit(const Params& P, LAS unsigned char* lds, int l, int ci, int g) {
    const int tid = opaque_tid(), lane = tid & 63, wave = tid >> 6;
    const bf16_t* PROJ = (const bf16_t*)(P.ws + WS_PROJ);
    const float* DT = (const float*)(P.ws + WS_DT);
    float* AC = (float*)(P.ws + WS_AC); float* CD = (float*)(P.ws + WS_CD);
    bf16_t* XTG = (bf16_t*)(P.ws + WS_XTG); bf16_t* BCN = (bf16_t*)(P.ws + WS_BCN); float* ST = (float*)(P.ws + WS_ST);
    LAS bf16_t* XTs = (LAS bf16_t*)lds;
    LAS bf16_t* BT = (LAS bf16_t*)(lds + 69632);
    LAS float* WG = (LAS float*)(lds + 104448);
    const int r0 = ci * 128, c = ci & 63;
    if (wave < 4) {
        const int h = 4 * g + wave; const float a = -__expf(P.in[I_ALOG][l * 8 + h]);
        const float d0 = DT[(size_t)(r0 + lane) * 8 + h], d1 = DT[(size_t)(r0 + 64 + lane) * 8 + h];
        float v0 = d0 * a, v1 = d1 * a;
#pragma unroll
        for (int o = 1; o < 64; o <<= 1) { const float t0 = __shfl_up(v0, o), t1 = __shfl_up(v1, o); if (lane >= o) { v0 += t0; v1 += t1; } }
        const float tot0 = __shfl(v0, 63); v1 += tot0;
        const float last = __shfl(v1, 63);
        AC[(size_t)(r0 + lane) * 8 + h] = v0; AC[(size_t)(r0 + 64 + lane) * 8 + h] = v1;
        WG[wave * 128 + lane] = __expf(last - v0) * d0; WG[wave * 128 + 64 + lane] = __expf(last - v1) * d1;
        if (lane == 0) CD[ci * 8 + h] = __expf(last);
    }
    __syncthreads();
    {
        const int cp = tid & 255, th = tid >> 8, lc = 2 * cp;
        int xc; if (lc < 256) xc = g * 256 + lc; else if (lc < 384) xc = 512 + g * 128 + (lc - 256); else xc = 768 + g * 128 + (lc - 384);
        const float* cw = P.in[I_CW] + (size_t)l * 4 * 1024 + xc; const float* cb = P.in[I_CB] + (size_t)l * 1024 + xc;
        const f32x2 w0 = *(const f32x2*)cw, w1 = *(const f32x2*)(cw + 1024), w2 = *(const f32x2*)(cw + 2048), w3 = *(const f32x2*)(cw + 3072), bb = *(const f32x2*)cb;
        const int t0 = 64 * th;
        const bf16_t* src = PROJ + (size_t)(r0 + t0) * NPROJ + PC_XBC + xc;
        f32x2 h0 = {0.f, 0.f}, h1 = {0.f, 0.f}, h2 = {0.f, 0.f};
        if (!(c == 0 && th == 0)) {
            const unsigned a = *(const unsigned*)(src - 3 * NPROJ), b = *(const unsigned*)(src - 2 * NPROJ), d = *(const unsigned*)(src - NPROJ);
            h0 = (f32x2){bf2f(a & 0xffffu), bf2f(a >> 16)}; h1 = (f32x2){bf2f(b & 0xffffu), bf2f(b >> 16)}; h2 = (f32x2){bf2f(d & 0xffffu), bf2f(d >> 16)};
        }
        const int hl = lc >> 6;
        for (int tb = 0; tb < 8; ++tb) {
            float o0[8], o1[8];
#pragma unroll
            for (int i = 0; i < 8; ++i) {
                const int t = t0 + 8 * tb + i;
                const unsigned a = *(const unsigned*)(src + (size_t)(8 * tb + i) * NPROJ);
                const f32x2 cur = {bf2f(a & 0xffffu), bf2f(a >> 16)};
                const f32x2 cv = w0 * h0 + w1 * h1 + w2 * h2 + w3 * cur + bb;
                h0 = h1; h1 = h2; h2 = cur;
                const float y0 = silu_f(cv[0]), y1 = silu_f(cv[1]);
                if (lc < 256) { o0[i] = y0; o1[i] = y1; }
                else { o0[i] = y0; o1[i] = y1; *(unsigned*)(BCN + (size_t)(r0 + t) * 512 + (lc < 384 ? g * 128 + (lc - 256) : 256 + g * 128 + (lc - 384))) = pk2(y0, y1); }
            }
            const int tt = t0 + 8 * tb;
            if (lc < 256) {
                u32x4 u0, u1; u0.x = pk2(o0[0], o0[1]); u0.y = pk2(o0[2], o0[3]); u0.z = pk2(o0[4], o0[5]); u0.w = pk2(o0[6], o0[7]);
                u1.x = pk2(o1[0], o1[1]); u1.y = pk2(o1[2], o1[3]); u1.z = pk2(o1[4], o1[5]); u1.w = pk2(o1[6], o1[7]);
                bf16_t* xg = XTG + ((size_t)ci * 512 + g * 256 + lc) * 128 + tt;
                *(u32x4*)xg = u0; *(u32x4*)(xg + 128) = u1;
                float s0[8], s1[8];
#pragma unroll
                for (int i = 0; i < 8; ++i) { const float w = WG[hl * 128 + tt + i]; s0[i] = o0[i] * w; s1[i] = o1[i] * w; }
                u0.x = pk2(s0[0], s0[1]); u0.y = pk2(s0[2], s0[3]); u0.z = pk2(s0[4], s0[5]); u0.w = pk2(s0[6], s0[7]);
                u1.x = pk2(s1[0], s1[1]); u1.y = pk2(s1[2], s1[3]); u1.z = pk2(s1[4], s1[5]); u1.w = pk2(s1[6], s1[7]);
                *(LAS u32x4*)(XTs + lc * 136 + tt) = u0; *(LAS u32x4*)(XTs + (lc + 1) * 136 + tt) = u1;
            } else if (lc < 384) {
                u32x4 u0, u1; u0.x = pk2(o0[0], o0[1]); u0.y = pk2(o0[2], o0[3]); u0.z = pk2(o0[4], o0[5]); u0.w = pk2(o0[6], o0[7]);
                u1.x = pk2(o1[0], o1[1]); u1.y = pk2(o1[2], o1[3]); u1.z = pk2(o1[4], o1[5]); u1.w = pk2(o1[6], o1[7]);
                *(LAS u32x4*)(BT + (lc - 256) * 136 + tt) = u0; *(LAS u32x4*)(BT + (lc - 255) * 136 + tt) = u1;
            }
        }
        if (c == 63 && th == 1) {
            float* o = P.out + O_PCONV + ((size_t)(l * 4 + (ci >> 6)) * 3) * 1024 + xc;
            *(f32x2*)o = h0; *(f32x2*)(o + 1024) = h1; *(f32x2*)(o + 2048) = h2;
        }
    }
    __syncthreads();
    {
        const int hl = wave >> 1, ph = wave & 1, r = lane & 15, q = lane >> 4;
        f32x4 acc[2][8];
#pragma unroll
        for (int mt = 0; mt < 2; ++mt)
#pragma unroll
            for (int nt = 0; nt < 8; ++nt) acc[mt][nt] = (f32x4){0.f, 0.f, 0.f, 0.f};
#pragma unroll
        for (int ks = 0; ks < 4; ++ks) {
            bf16x8 xf[2];
#pragma unroll
            for (int mt = 0; mt < 2; ++mt) xf[mt] = *(const LAS bf16x8*)(XTs + (hl * 64 + 32 * ph + 16 * mt + r) * 136 + 32 * ks + 8 * q);
#pragma unroll
            for (int nt = 0; nt < 8; ++nt) { const bf16x8 bf = *(const LAS bf16x8*)(BT + (16 * nt + r) * 136 + 32 * ks + 8 * q);
#pragma unroll
                for (int mt = 0; mt < 2; ++mt) acc[mt][nt] = __builtin_amdgcn_mfma_f32_16x16x32_bf16(bf, xf[mt], acc[mt][nt], 0, 0, 0); }
        }
        float* sp = ST + ((size_t)(ci * 8 + 4 * g + hl) * 64) * 128;
#pragma unroll
        for (int mt = 0; mt < 2; ++mt)
#pragma unroll
            for (int nt = 0; nt < 8; ++nt) *(f32x4*)(sp + (size_t)(32 * ph + 16 * mt + r) * 128 + 16 * nt + 4 * q) = acc[mt][nt];
    }
    __syncthreads();
}

__device__ __forceinline__ void attn_prompt_unit(const Params& P, LAS unsigned char* lds, int l, int b, int qb, int kvh) {
    const int tid = opaque_tid(), lane = tid & 63, wave = tid >> 6;
    const bf16_t* PROJ = (const bf16_t*)(P.ws + WS_PROJ); bf16_t* YCAT = (bf16_t*)(P.ws + WS_YCAT);
    LAS bf16_t* Ks = (LAS bf16_t*)lds;
    LAS bf16_t* VT = (LAS bf16_t*)(lds + 36864);
    const int r1 = b * 8192 + qb * 128;
    {
        const int key = tid >> 1, half = tid & 1; const int row = r1 - 128 + key; const bool ok = (qb > 0) || (key >= 128);
        float kx[32], vx[32];
        if (ok) {
            const bf16_t* kp = PROJ + (size_t)row * NPROJ + PC_K + kvh * 64 + 32 * half; const bf16_t* vp = PROJ + (size_t)row * NPROJ + PC_V + kvh * 64 + 32 * half;
#pragma unroll
            for (int i = 0; i < 4; ++i) { const u32x4 a = *(const u32x4*)(kp + 8 * i), v = *(const u32x4*)(vp + 8 * i);
#pragma unroll
                for (int e = 0; e < 4; ++e) { kx[8 * i + 2 * e] = bf2f(a[e] & 0xffffu); kx[8 * i + 2 * e + 1] = bf2f(a[e] >> 16); vx[8 * i + 2 * e] = bf2f(v[e] & 0xffffu); vx[8 * i + 2 * e + 1] = bf2f(v[e] >> 16); } }
        } else {
#pragma unroll
            for (int i = 0; i < 32; ++i) { kx[i] = 0.f; vx[i] = 0.f; }
        }
        float ss = 0.f;
#pragma unroll
        for (int i = 0; i < 32; ++i) ss += kx[i] * kx[i];
        ss += __shfl_xor(ss, 1);
        const float rs = rsqrtf(ss * (1.f / 64.f) + EPS);
        const float* kw = P.in[I_KN] + l * 64 + 32 * half;
#pragma unroll
        for (int i = 0; i < 32; ++i) kx[i] = kx[i] * rs * kw[i];
#pragma unroll
        for (int i = 0; i < 4; ++i) { u32x4 w; w.x = pk2(kx[8 * i], kx[8 * i + 1]); w.y = pk2(kx[8 * i + 2], kx[8 * i + 3]); w.z = pk2(kx[8 * i + 4], kx[8 * i + 5]); w.w = pk2(kx[8 * i + 6], kx[8 * i + 7]);
            *(LAS u32x4*)(Ks + key * 72 + 32 * half + 8 * i) = w; }
#pragma unroll
        for (int i = 0; i < 32; ++i) VT[(32 * half + i) * 264 + key] = (bf16_t)(pk2(vx[i], 0.f) & 0xffffu);
        if (qb == 63 && key >= 128) {
            float* ko = P.out + O_PK + (((size_t)(l * 4 + b) * 128 + (key - 128)) * 2 + kvh) * 64 + 32 * half; float* vo = P.out + O_PV + (((size_t)(l * 4 + b) * 128 + (key - 128)) * 2 + kvh) * 64 + 32 * half;
#pragma unroll
            for (int i = 0; i < 8; ++i) { *(f32x4*)(ko + 4 * i) = (f32x4){kx[4 * i], kx[4 * i + 1], kx[4 * i + 2], kx[4 * i + 3]}; *(f32x4*)(vo + 4 * i) = (f32x4){vx[4 * i], vx[4 * i + 1], vx[4 * i + 2], vx[4 * i + 3]}; }
        }
    }
    __syncthreads();
    {
        const int g = wave >> 1, qh = wave & 1, r = lane & 15, q = lane >> 4, head = kvh * 4 + g;
        const float slope = exp2f(-(float)(head + 1)), sink = P.in[I_SINK][l * 8 + head];
#pragma unroll 1
        for (int it = 0; it < 4; ++it) {
            const int i0 = 64 * qh + 16 * it; const int row = r1 + i0 + r;
            attn_tile(PROJ + (size_t)row * NPROJ + PC_Q + head * 64, P.in[I_QN] + l * 64, Ks, VT, i0, r + 128, (qb > 0) ? 0 : 128 - i0, 144, slope, sink,
                      YCAT + (size_t)row * DM + 512 + head * 64, r, q);
        }
    }
    __syncthreads();
}

__device__ __forceinline__ void ssd_sample_unit(const Params& P, LAS unsigned char* lds, int l, int b, int g) {
    const int tid = opaque_tid();
    const bf16_t* PROJ = (const bf16_t*)(P.ws + WS_PROJ); const float* DT = (const float*)(P.ws + WS_DT); bf16_t* YCAT = (bf16_t*)(P.ws + WS_YCAT);
    LAS float* XV = (LAS float*)lds;
    LAS float* YZ = (LAS float*)(lds + 8192);
    LAS float* RS = (LAS float*)(lds + 12288);
    const int rs0 = MP + 4 * b;
    {
        const int lc = tid; int xc; if (lc < 256) xc = g * 256 + lc; else if (lc < 384) xc = 512 + g * 128 + (lc - 256); else xc = 768 + g * 128 + (lc - 384);
        const float* cw = P.in[I_CW] + (size_t)l * 4 * 1024 + xc; const float w0 = cw[0], w1 = cw[1024], w2 = cw[2048], w3 = cw[3072], bb = P.in[I_CB][l * 1024 + xc];
        const float* sp = P.in[I_SCONV] + ((size_t)(l * 128 + b) * 3) * 1024 + xc;
        float h0 = sp[0], h1 = sp[1024], h2 = sp[2048];
#pragma unroll
        for (int t = 0; t < 4; ++t) {
            const float cur = bf2f(PROJ[(size_t)(rs0 + t) * NPROJ + PC_XBC + xc]);
            const float cv = w0 * h0 + w1 * h1 + w2 * h2 + w3 * cur + bb;
            h0 = h1; h1 = h2; h2 = cur;
            XV[t * 512 + lc] = silu_f(cv);
        }
        float* o = P.out + O_SCONV + ((size_t)(l * 128 + b) * 3) * 1024 + xc; o[0] = h0; o[1024] = h1; o[2048] = h2;
    }
    __syncthreads();
    {
        const int hl = tid >> 7, p = (tid & 127) >> 1, nh = tid & 1, h = 4 * g + hl;
        const float a = -__expf(P.in[I_ALOG][l * 8 + h]), dsk = P.in[I_DSKIP][l * 8 + h];
        const float* sin_ = P.in[I_SSM] + (((size_t)(l * 128 + b) * 8 + h) * 64 + p) * 128 + 64 * nh;
        float* sout = P.out + O_SSSM + (((size_t)(l * 128 + b) * 8 + h) * 64 + p) * 128 + 64 * nh;
        f32x4 st[16];
#pragma unroll
        for (int i = 0; i < 16; ++i) st[i] = *(const f32x4*)(sin_ + 4 * i);
#pragma unroll
        for (int t = 0; t < 4; ++t) {
            const float dt = DT[(size_t)(rs0 + t) * 8 + h], dA = __expf(dt * a), x = XV[t * 512 + hl * 64 + p], xdt = x * dt;
            float y = 0.f;
#pragma unroll
            for (int i = 0; i < 16; ++i) { const f32x4 bv = *(const LAS f32x4*)(XV + t * 512 + 256 + 64 * nh + 4 * i), cv = *(const LAS f32x4*)(XV + t * 512 + 384 + 64 * nh + 4 * i);
                st[i] = st[i] * dA + xdt * bv; y += (st[i][0] * cv[0] + st[i][1] * cv[1]) + (st[i][2] * cv[2] + st[i][3] * cv[3]); }
            y += __shfl_xor(y, 1);
            y += dsk * x;
            const float z = bf2f(PROJ[(size_t)(rs0 + t) * NPROJ + PC_Z + h * 64 + p]);
            if (nh == 0) YZ[t * 256 + hl * 64 + p] = y * silu_f(z);
        }
#pragma unroll
        for (int i = 0; i < 16; ++i) *(f32x4*)(sout + 4 * i) = st[i];
    }
    __syncthreads();
    {
        const int wave = tid >> 6, lane = tid & 63;
        if (wave < 4) { float s = 0.f;
#pragma unroll
            for (int i = 0; i < 4; ++i) { const float v = YZ[wave * 256 + lane + 64 * i]; s += v * v; }
            s = wave_sum(s); if (lane == 0) RS[wave] = rsqrtf(s * (1.f / 256.f) + EPS); }
    }
    __syncthreads();
    for (int e = tid; e < 1024; e += 512) { const int t = e >> 8, ch = e & 255;
        YCAT[(size_t)(rs0 + t) * DM + g * 256 + ch] = (bf16_t)(pk2(YZ[e] * RS[t] * P.in[I_SNORM][l * 512 + g * 256 + ch], 0.f) & 0xffffu); }
    __syncthreads();
}

__device__ __forceinline__ void attn_sample_unit(const Params& P, LAS unsigned char* lds, int l, int b, int kvh) {
    const int tid = opaque_tid(), lane = tid & 63, wave = tid >> 6;
    const bf16_t* PROJ = (const bf16_t*)(P.ws + WS_PROJ); bf16_t* YCAT = (bf16_t*)(P.ws + WS_YCAT);
    LAS bf16_t* Ks = (LAS bf16_t*)lds; LAS bf16_t* VT = (LAS bf16_t*)(lds + 36864);
    const int rs0 = MP + 4 * b;
    {
        const int key = tid >> 2, qt = tid & 3;
        const float* kp = P.in[I_CK] + (((size_t)(l * 128 + b) * 128 + key) * 2 + kvh) * 64 + 16 * qt; const float* vp = P.in[I_CV] + (((size_t)(l * 128 + b) * 128 + key) * 2 + kvh) * 64 + 16 * qt;
        f32x4 k4[4], v4[4];
#pragma unroll
        for (int i = 0; i < 4; ++i) { k4[i] = *(const f32x4*)(kp + 4 * i); v4[i] = *(const f32x4*)(vp + 4 * i); }
        *(LAS u32x4*)(Ks + key * 72 + 16 * qt) = __builtin_bit_cast(u32x4, cvt8(k4[0], k4[1])); *(LAS u32x4*)(Ks + key * 72 + 16 * qt + 8) = __builtin_bit_cast(u32x4, cvt8(k4[2], k4[3]));
#pragma unroll
        for (int i = 0; i < 4; ++i)
#pragma unroll
            for (int e = 0; e < 4; ++e) VT[(16 * qt + 4 * i + e) * 264 + key] = (bf16_t)(pk2(v4[i][e], 0.f) & 0xffffu);
        if (key >= 4) {
            float* ko = P.out + O_SK + (((size_t)(l * 128 + b) * 128 + (key - 4)) * 2 + kvh) * 64 + 16 * qt; float* vo = P.out + O_SV + (((size_t)(l * 128 + b) * 128 + (key - 4)) * 2 + kvh) * 64 + 16 * qt;
#pragma unroll
            for (int i = 0; i < 4; ++i) { *(f32x4*)(ko + 4 * i) = k4[i]; *(f32x4*)(vo + 4 * i) = v4[i]; }
        }
    }
    if (tid < 64) {
        const int t = tid >> 4, d4 = (tid & 15) * 4;
        const bf16_t* kp = PROJ + (size_t)(rs0 + t) * NPROJ + PC_K + kvh * 64 + d4; const bf16_t* vp = PROJ + (size_t)(rs0 + t) * NPROJ + PC_V + kvh * 64 + d4;
        const u32x2 a = *(const u32x2*)kp, v = *(const u32x2*)vp;
        float kx[4] = {bf2f(a.x & 0xffffu), bf2f(a.x >> 16), bf2f(a.y & 0xffffu), bf2f(a.y >> 16)}, vx[4] = {bf2f(v.x & 0xffffu), bf2f(v.x >> 16), bf2f(v.y & 0xffffu), bf2f(v.y >> 16)};
        float ss = (kx[0] * kx[0] + kx[1] * kx[1]) + (kx[2] * kx[2] + kx[3] * kx[3]);
        ss += __shfl_xor(ss, 1); ss += __shfl_xor(ss, 2); ss += __shfl_xor(ss, 4); ss += __shfl_xor(ss, 8);
        const float rs = rsqrtf(ss * (1.f / 64.f) + EPS);
        const f32x4 kw = *(const f32x4*)(P.in[I_KN] + l * 64 + d4);
#pragma unroll
        for (int e = 0; e < 4; ++e) kx[e] = kx[e] * rs * kw[e];
        u32x2 w; w.x = pk2(kx[0], kx[1]); w.y = pk2(kx[2], kx[3]); *(LAS u32x2*)(Ks + (128 + t) * 72 + d4) = w;
#pragma unroll
        for (int e = 0; e < 4; ++e) VT[(d4 + e) * 264 + 128 + t] = (bf16_t)(pk2(vx[e], 0.f) & 0xffffu);
        float* ko = P.out + O_SK + (((size_t)(l * 128 + b) * 128 + (124 + t)) * 2 + kvh) * 64 + d4; float* vo = P.out + O_SV + (((size_t)(l * 128 + b) * 128 + (124 + t)) * 2 + kvh) * 64 + d4;
        *(f32x4*)ko = (f32x4){kx[0], kx[1], kx[2], kx[3]}; *(f32x4*)vo = (f32x4){vx[0], vx[1], vx[2], vx[3]};
    } else if (tid < 128) {
        const int e = tid - 64;
        for (int i = e; i < 12 * 64; i += 64) Ks[(132 + i / 64) * 72 + (i & 63)] = 0;
        for (int i = e; i < 64 * 12; i += 64) VT[(i / 12) * 264 + 132 + (i % 12)] = 0;
    }
    __syncthreads();
    if (wave == 0) {
        const int r = lane & 15, q = lane >> 4, g = r >> 2, t = r & 3, head = kvh * 4 + g;
        const float slope = exp2f(-(float)(head + 1)), sink = P.in[I_SINK][l * 8 + head];
        attn_tile(PROJ + (size_t)(rs0 + t) * NPROJ + PC_Q + head * 64, P.in[I_QN] + l * 64, Ks, VT, 0, t + 128, 0, 132, slope, sink,
                  YCAT + (size_t)(rs0 + t) * DM + 512 + head * 64, r, q);
    }
    __syncthreads();
}

__device__ __forceinline__ void phase_scan(const Params& P, int l) {
    float* ST = (float*)(P.ws + WS_ST); const float* CD = (const float*)(P.ws + WS_CD);
    for (int idx = blockIdx.x * 512 + opaque_tid(); idx < 131072; idx += gridDim.x * 512) {
        const int b = idx >> 15, rem = idx & 32767, h = rem >> 12, e2 = rem & 4095;
        f32x2 carry = {0.f, 0.f};
        for (int c0 = 0; c0 < 64; c0 += 8) {
            f32x2 v[8]; float dc[8];
#pragma unroll
            for (int i = 0; i < 8; ++i) { v[i] = *(const f32x2*)(ST + ((size_t)((b * 64 + c0 + i) * 8 + h)) * 8192 + 2 * e2); dc[i] = CD[(b * 64 + c0 + i) * 8 + h]; }
#pragma unroll
            for (int i = 0; i < 8; ++i) { const f32x2 prev = carry; carry = carry * dc[i] + v[i]; *(f32x2*)(ST + ((size_t)((b * 64 + c0 + i) * 8 + h)) * 8192 + 2 * e2) = prev; }
        }
        *(f32x2*)(P.out + O_PSSM + ((size_t)((l * 4 + b) * 8 + h)) * 8192 + 2 * e2) = carry;
    }
}

__device__ __forceinline__ void ssd_out_unit(const Params& P, LAS unsigned char* lds, int l, int ci, int g) {
    const int tid = opaque_tid(), lane = tid & 63, wave = tid >> 6;
    const bf16_t* PROJ = (const bf16_t*)(P.ws + WS_PROJ); const float* DT = (const float*)(P.ws + WS_DT); const float* AC = (const float*)(P.ws + WS_AC);
    const bf16_t* XTG = (const bf16_t*)(P.ws + WS_XTG); const bf16_t* BCN = (const bf16_t*)(P.ws + WS_BCN); const float* ST = (const float*)(P.ws + WS_ST);
    bf16_t* YCAT = (bf16_t*)(P.ws + WS_YCAT);
    LAS bf16_t* XT = (LAS bf16_t*)lds;
    LAS bf16_t* Bn = (LAS bf16_t*)(lds + 69632);
    LAS bf16_t* Cn = (LAS bf16_t*)(lds + 104448);
    LAS float* ACs = (LAS float*)(lds + 139264);
    LAS float* DTs = (LAS float*)(lds + 141312);
    const int r0 = ci * 128;
    for (int e = tid; e < 4096; e += 512) { const int row = e >> 4, pc = e & 15; *(LAS u32x4*)(XT + row * 136 + 8 * pc) = *(const u32x4*)(XTG + ((size_t)ci * 512 + g * 256 + row) * 128 + 8 * pc); }
    for (int e = tid; e < 2048; e += 512) { const int row = e >> 4, pc = e & 15;
        *(LAS u32x4*)(Bn + row * 136 + 8 * pc) = *(const u32x4*)(BCN + (size_t)(r0 + row) * 512 + g * 128 + 8 * pc);
        *(LAS u32x4*)(Cn + row * 136 + 8 * pc) = *(const u32x4*)(BCN + (size_t)(r0 + row) * 512 + 256 + g * 128 + 8 * pc); }
    { const int hl = tid >> 7, t = tid & 127; ACs[hl * 128 + t] = AC[(size_t)(r0 + t) * 8 + 4 * g + hl]; DTs[hl * 128 + t] = DT[(size_t)(r0 + t) * 8 + 4 * g + hl]; }
    __syncthreads();
    {
        const int nt = wave, r = lane & 15, q = lane >> 4, lrow = 16 * nt + r;
        bf16x8 cf[4];
#pragma unroll
        for (int ks = 0; ks < 4; ++ks) cf[ks] = *(const LAS bf16x8*)(Cn + lrow * 136 + 32 * ks + 8 * q);
        f32x4 gt[8];
#pragma unroll
        for (int st = 0; st < 8; ++st) {
            gt[st] = (f32x4){0.f, 0.f, 0.f, 0.f};
            if (st <= nt) {
#pragma unroll
                for (int ks = 0; ks < 4; ++ks) gt[st] = __builtin_amdgcn_mfma_f32_16x16x32_bf16(*(const LAS bf16x8*)(Bn + (16 * st + r) * 136 + 32 * ks + 8 * q), cf[ks], gt[st], 0, 0, 0);
            }
        }
        unsigned yzp[4][8]; float ss = 0.f;
        const int grow = r0 + lrow;
#pragma unroll
        for (int hl = 0; hl < 4; ++hl) {
            const int h = 4 * g + hl;
            f32x4 acc[4];
#pragma unroll
            for (int mt = 0; mt < 4; ++mt) acc[mt] = (f32x4){0.f, 0.f, 0.f, 0.f};
            const float* pv = ST + ((size_t)(ci * 8 + h) * 64) * 128;
#pragma unroll
            for (int ks = 0; ks < 4; ++ks) {
                __builtin_amdgcn_sched_barrier(0);
#pragma unroll
                for (int mt = 0; mt < 4; ++mt) { const float* pp = pv + (size_t)(16 * mt + r) * 128 + 32 * ks + 8 * q;
                    const bf16x8 af = cvt8(*(const f32x4*)pp, *(const f32x4*)(pp + 4));
                    acc[mt] = __builtin_amdgcn_mfma_f32_16x16x32_bf16(af, cf[ks], acc[mt], 0, 0, 0); }
            }
            __builtin_amdgcn_sched_barrier(0);
            const float al = ACs[hl * 128 + lrow], el = __expf(al);
#pragma unroll
            for (int mt = 0; mt < 4; ++mt) acc[mt] = acc[mt] * el;
#pragma unroll
            for (int kk = 0; kk < 4; ++kk) {
                __builtin_amdgcn_sched_barrier(0);
                if (2 * kk <= nt) {
                    f32x4 wv[2];
#pragma unroll
                    for (int hf = 0; hf < 2; ++hf) { const int st = 2 * kk + hf;
                        const f32x4 as = *(const LAS f32x4*)(ACs + hl * 128 + 16 * st + 4 * q), ds = *(const LAS f32x4*)(DTs + hl * 128 + 16 * st + 4 * q);
#pragma unroll
                        for (int j = 0; j < 4; ++j) { const int s = 16 * st + 4 * q + j; wv[hf][j] = (s <= lrow) ? gt[st][j] * __expf(al - as[j]) * ds[j] : 0.f; } }
                    const bf16x8 wf = cvt8(wv[0], wv[1]);
#pragma unroll
                    for (int mt = 0; mt < 4; ++mt) { const LAS bf16_t* xp = XT + (hl * 64 + 16 * mt + r) * 136 + 32 * kk + 4 * q;
                        const u32x2 lo = *(const LAS u32x2*)xp, hi = *(const LAS u32x2*)(xp + 16); u32x4 w; w.x = lo.x; w.y = lo.y; w.z = hi.x; w.w = hi.y;
                        acc[mt] = __builtin_amdgcn_mfma_f32_16x16x32_bf16(__builtin_bit_cast(bf16x8, w), wf, acc[mt], 0, 0, 0); }
                }
            }
            __builtin_amdgcn_sched_barrier(0);
            const float dsk = P.in[I_DSKIP][l * 8 + h];
#pragma unroll
            for (int mt = 0; mt < 4; ++mt) { const u32x2 zz = *(const u32x2*)(PROJ + (size_t)grow * NPROJ + PC_Z + h * 64 + 16 * mt + 4 * q);
                const float z[4] = {bf2f(zz.x & 0xffffu), bf2f(zz.x >> 16), bf2f(zz.y & 0xffffu), bf2f(zz.y >> 16)};
                float yv[4];
#pragma unroll
                for (int j = 0; j < 4; ++j) { const float x = bf2f(XT[(hl * 64 + 16 * mt + 4 * q + j) * 136 + lrow]); const float y = (acc[mt][j] + dsk * x) * silu_f(z[j]); yv[j] = y; ss += y * y; }
                yzp[hl][2 * mt] = pk2(yv[0], yv[1]); yzp[hl][2 * mt + 1] = pk2(yv[2], yv[3]); }
        }
        ss += __shfl_xor(ss, 16); ss += __shfl_xor(ss, 32);
        const float rstd = rsqrtf(ss * (1.f / 256.f) + EPS);
        const float* nw = P.in[I_SNORM] + l * 512 + g * 256;
#pragma unroll
        for (int hl = 0; hl < 4; ++hl)
#pragma unroll
            for (int mt = 0; mt < 4; ++mt) { const f32x4 w4 = *(const f32x4*)(nw + hl * 64 + 16 * mt + 4 * q);
                const unsigned a = yzp[hl][2 * mt], b = yzp[hl][2 * mt + 1];
                u32x2 o; o.x = pk2(bf2f(a & 0xffffu) * rstd * w4[0], bf2f(a >> 16) * rstd * w4[1]); o.y = pk2(bf2f(b & 0xffffu) * rstd * w4[2], bf2f(b >> 16) * rstd * w4[3]);
                *(u32x2*)(YCAT + (size_t)grow * DM + g * 256 + hl * 64 + 16 * mt + 4 * q) = o; }
    }
    __syncthreads();
}

__device__ __forceinline__ void phase_fixup(const Params& P, int l) {
    const float* UH = (const float*)(P.ws + WS_UH); bf16_t* G = (bf16_t*)(P.ws + WS_G);
    const float* cw = P.in[I_FCW] + (size_t)l * 3 * NUP; const float* cb = P.in[I_FCB] + (size_t)l * NUP;
    for (int gi = blockIdx.x; gi < 512; gi += gridDim.x) {
        const bool first = (gi & 127) == 0;
        const float* cur = UH + (size_t)gi * 4 * NUP; const float* prv = UH + (size_t)(gi - 1) * 4 * NUP;
        for (int j = opaque_tid(); j < DFF; j += 512) {
            float cvv[2][2];
#pragma unroll
            for (int gv = 0; gv < 2; ++gv) { const int c = j + gv * DFF;
                const float w0 = cw[c], w1 = cw[NUP + c], w2 = cw[2 * NUP + c], bb = cb[c];
                const float u0 = cur[c], u1 = cur[NUP + c]; const float pm2 = first ? 0.f : prv[2 * NUP + c], pm1 = first ? 0.f : prv[3 * NUP + c];
                cvv[0][gv] = w0 * pm2 + w1 * pm1 + w2 * u0 + bb; cvv[1][gv] = w0 * pm1 + w1 * u0 + w2 * u1 + bb; }
            G[(size_t)(64 * gi) * DFF + j] = (bf16_t)(pk2(silu_f(cvv[0][0]) * cvv[0][1], 0.f) & 0xffffu);
            G[(size_t)(64 * gi + 1) * DFF + j] = (bf16_t)(pk2(silu_f(cvv[1][0]) * cvv[1][1], 0.f) & 0xffffu);
        }
        if ((gi & 127) == 127) { float* o = P.out + O_PFFN + ((size_t)(l * 4 + (gi >> 7)) * 2) * NUP;
            for (int c = opaque_tid(); c < 2 * NUP; c += 512) o[c] = cur[2 * NUP + c]; }
    }
}

constexpr int N_PHASES = 21;
#ifndef ONLY_K
#define ONLY_K -1
#endif
#ifndef ONLY_U
#define ONLY_U -1
#endif
#define ENU(uu) (ONLY_U < 0 || ONLY_U == (uu))
#define EN(kk) (ONLY_K < 0 || ONLY_K == (kk))
__global__ void __launch_bounds__(512, 2) fwd_megakernel(Params P) {
    extern __shared__ __attribute__((aligned(16))) unsigned char lds_raw[];
    LAS unsigned char* lds = (LAS unsigned char*)lds_raw;
    cg::grid_group grid = cg::this_grid();
    float* X = P.out;
    for (int ph = P.ph_lo; ph < P.ph_hi; ++ph) {
        if (ph == 0) { if (EN(10)) phase_weights(P, lds); }
        else {
            int phv = ph, gdim = gridDim.x, bidx = blockIdx.x; asm volatile("" : "+s"(phv), "+s"(gdim), "+s"(bidx));
            const int l = (phv - 1) / 10, k = (phv - 1) % 10;
            const float* xP = (l == 0) ? P.in[I_XP] : X; const float* xS = (l == 0) ? P.in[I_XS] : X + (size_t)MP * DM;
            if (k == 0) { if (EN(0)) phase_norm<true>(P, lds, l, xP, xS, P.in[I_N1] + l * DM); }
            else if (k == 1 && EN(1)) {
                pg8::Gemm g{(const bf16_t*)(P.ws + WS_HN), (const bf16_t*)(P.ws + WS_WIN + l * WIN_L), MT, NPROJ, DM}; pg8::StaticOrder S; S.init(MT, NPROJ, gdim, bidx);
                pg8::EpiProj E{(bf16_t*)(P.ws + WS_PROJ), NPROJ};
                pg8::gemm_phase<pg8::EpiProj, pg8::StaticOrder, false>(lds, g, S, E, nullptr);
            } else if (k == 2 && EN(2)) {
#pragma unroll 1
                for (int u = blockIdx.x; u < 512; u += gridDim.x) { if (ENU(0)) ssd_prep_unit(P, lds, l, u >> 1, u & 1); }
#pragma unroll 1
                for (int v = blockIdx.x; v < 512; v += gridDim.x) { if (ENU(1)) attn_prompt_unit(P, lds, l, v >> 7, (v >> 1) & 63, v & 1); }
#pragma unroll 1
                for (int v = blockIdx.x; v < 256; v += gridDim.x) { if (ENU(2)) ssd_sample_unit(P, lds, l, v >> 1, v & 1); }
#pragma unroll 1
                for (int v = blockIdx.x; v < 256; v += gridDim.x) { if (ENU(3)) attn_sample_unit(P, lds, l, v >> 1, v & 1); }
            } else if (k == 3 && EN(3)) phase_scan(P, l);
            else if (k == 4 && EN(4)) {
#pragma unroll 1
                for (int u = blockIdx.x; u < 512; u += gridDim.x) ssd_out_unit(P, lds, l, u >> 1, u & 1); }
            else if (k == 5 && EN(5)) {
                pg8::Gemm g{(const bf16_t*)(P.ws + WS_YCAT), (const bf16_t*)(P.ws + WS_WOUT + l * WOUT_L), MT, DM, DM}; pg8::StaticOrder S; S.init(MT, DM, gdim, bidx);
                pg8::EpiResid E{xP, xS, X};
                pg8::gemm_phase<pg8::EpiResid, pg8::StaticOrder, false>(lds, g, S, E, nullptr);
            } else if (k == 6 && EN(6)) phase_norm<false>(P, lds, l, X, X + (size_t)MP * DM, P.in[I_N2] + l * DM);
            else if (k == 7 && EN(7)) {
                pg8::Gemm g{(const bf16_t*)(P.ws + WS_HN), (const bf16_t*)(P.ws + WS_WUP + l * WUP_L), MT, NUP, DM}; pg8::StaticOrder S; S.init(MT, NUP, gdim, bidx);
                pg8::EpiUp E{(bf16_t*)(P.ws + WS_G), (float*)(P.ws + WS_UH), P.in[I_FCW] + (size_t)l * 3 * NUP, P.in[I_FCB] + (size_t)l * NUP,
                             P.in[I_SFFN] + (size_t)l * 128 * 2 * NUP, P.out + O_SFFN + (size_t)l * 128 * 2 * NUP};
                pg8::gemm_phase<pg8::EpiUp, pg8::StaticOrder, false>(lds, g, S, E, nullptr);
            } else if (k == 8 && EN(8)) phase_fixup(P, l);
            else if (k == 9 && EN(9)) {
                pg8::Gemm g{(const bf16_t*)(P.ws + WS_G), (const bf16_t*)(P.ws + WS_WDN + l * WDN_L), MT, DM, DFF}; pg8::StaticOrder S; S.init(MT, DM, gdim, bidx);
                pg8::EpiResid E{X, X + (size_t)MP * DM, X};
                pg8::gemm_phase<pg8::EpiResid, pg8::StaticOrder, false>(lds, g, S, E, nullptr);
            }
        }
        if (ph + 1 < P.ph_hi) { __syncthreads(); grid.sync(); }
    }
}

extern "C" void kernel_launch(void* const* d_in, const int* in_sizes, int n_in, void* d_out, int out_size, void* d_ws, size_t ws_size, hipStream_t stream) {
    static int grid = 0;
    if (grid == 0) {
        if (n_in != 24 || ws_size < WS_END) { fprintf(stderr, "kernel_launch: unexpected inputs (n_in %d, ws %zu)\n", n_in, ws_size); grid = -1; return; }
        int dev = 0, cus = 0, per_cu = 0;
        hipGetDevice(&dev); hipDeviceGetAttribute(&cus, hipDeviceAttributeMultiprocessorCount, dev);
        hipFuncSetAttribute((const void*)fwd_megakernel, hipFuncAttributeMaxDynamicSharedMemorySize, LDS_BYTES);
        hipOccupancyMaxActiveBlocksPerMultiprocessor(&per_cu, (const void*)fwd_megakernel, 512, LDS_BYTES);
        (void)hipGetLastError();
        if (per_cu < 1) fprintf(stderr, "kernel_launch: occupancy query says %d blocks/CU\n", per_cu);
        grid = cus > 0 ? cus : 256;
    }
    if (grid < 0) return;
    Params p{};
    for (int i = 0; i < 24; ++i) p.in[i] = (const float*)d_in[i];
    p.out = (float*)d_out; p.ws = (unsigned char*)d_ws;
#if MK_MULTI
    for (int ph = 0; ph < N_PHASES; ++ph) { p.ph_lo = ph; p.ph_hi = ph + 1; hipLaunchKernelGGL(fwd_megakernel, dim3(grid), dim3(512), LDS_BYTES, stream, p); }
#else
    p.ph_lo = 0; p.ph_hi = N_PHASES;
    void* args[] = {&p};
    hipError_t e = hipLaunchCooperativeKernel((const void*)fwd_megakernel, dim3(grid), dim3(512), args, LDS_BYTES, stream);
    if (e != hipSuccess) fprintf(stderr, "cooperative launch failed: %s (grid %d)\n", hipGetErrorString(e), grid);
#endif
}
```

```cpp
#include <hip/hip_runtime.h>
#include <hip/hip_cooperative_groups.h>
#include <cstdio>
#include <cstdint>
namespace cg = cooperative_groups;

#define LAS __attribute__((address_space(3)))
typedef unsigned short bf16_t;
typedef short bf16x8 __attribute__((ext_vector_type(8)));
typedef short bf16x4 __attribute__((ext_vector_type(4)));
typedef float f32x4 __attribute__((ext_vector_type(4)));
typedef float f32x2 __attribute__((ext_vector_type(2)));
typedef unsigned u32x4 __attribute__((ext_vector_type(4)));
typedef unsigned u32x2 __attribute__((ext_vector_type(2)));

#ifndef MK_MULTI
#define MK_MULTI 0
#endif

constexpr int MP = 32768, MS = 512, MT = MP + MS;
constexpr int DM = 1024, NPROJ = 2304, DFF = 2816, NUP = 5632, IN_DIM = 2312;
constexpr int PC_Z = 0, PC_XBC = 512, PC_Q = 1536, PC_K = 2048, PC_V = 2176;
constexpr float EPS = 1e-6f;
constexpr size_t O_Y = 0, O_PSSM = 34078720, O_PCONV = 34603008, O_PK = 34627584, O_PV = 34758656, O_PFFN = 34889728,
                 O_SSSM = 34979840, O_SCONV = 51757056, O_SK = 52543488, O_SV = 56737792, O_SFFN = 60932096;
constexpr size_t MiB = 1u << 20;
constexpr size_t WS_CTL = 0, WS_WIN = 1 * MiB, WS_WOUT = 10 * MiB, WS_WUP = 14 * MiB, WS_WDN = 36 * MiB, WS_HN = 47 * MiB,
                 WS_DT = 112 * MiB, WS_AC = 112 * MiB + 1310720, WS_CD = 112 * MiB + 2621440, WS_XS = 115 * MiB  , WS_XB = 394 * MiB  , WS_YCAT = 117 * MiB, WS_PROJ = 182 * MiB,
                 WS_XTG = 329 * MiB, WS_BCN = 361 * MiB, WS_ST = 394 * MiB, WS_G = 182 * MiB, WS_UH = 361 * MiB, WS_PSTB = 458 * MiB, WS_US = 117 * MiB  , WS_XSL = 458 * MiB  , WS_END = 490 * MiB;
constexpr size_t WIN_L = (size_t)NPROJ * DM * 2, WOUT_L = (size_t)DM * DM * 2, WUP_L = (size_t)NUP * DM * 2, WDN_L = (size_t)DM * DFF * 2;
constexpr int LDS_BYTES = 155648;

__device__ __forceinline__ float bf2f(unsigned b) { return __uint_as_float(b << 16); }
__device__ __forceinline__ unsigned pk2(float lo, float hi) { unsigned r; asm volatile("v_cvt_pk_bf16_f32 %0, %1, %2" : "=v"(r) : "v"(lo), "v"(hi)); return r; }
__device__ __forceinline__ float silu_f(float x) { return x * __builtin_amdgcn_rcpf(1.f + __expf(-x)); }

template <int CTRL> __device__ __forceinline__ float dpp0(float x) {
    return __builtin_bit_cast(float, __builtin_amdgcn_update_dpp(0, __builtin_bit_cast(int, x), CTRL, 0xf, 0xf, true));
}
#define DPP_SHR1 0x111
#define DPP_SHR2 0x112
#define DPP_SHL14 0x10E
#define DPP_SHL15 0x10F
__device__ __forceinline__ bf16x8 cvt8(const f32x4 a, const f32x4 b) {
    u32x4 w; w.x = pk2(a[0], a[1]); w.y = pk2(a[2], a[3]); w.z = pk2(b[0], b[1]); w.w = pk2(b[2], b[3]);
    return __builtin_bit_cast(bf16x8, w);
}
__device__ __forceinline__ int lane_now() { int l; asm volatile("v_mbcnt_lo_u32_b32 %0, -1, 0\n\tv_mbcnt_hi_u32_b32 %0, -1, %0" : "=v"(l)); return l; }
__device__ __forceinline__ int opaque_tid(int wbase) { return wbase + lane_now(); }
__device__ __forceinline__ float shx(float v, int o, int lane) { return __builtin_bit_cast(float, __builtin_amdgcn_ds_bpermute((lane ^ o) << 2, __builtin_bit_cast(int, v))); }
__device__ __forceinline__ float shi(float v, int idx) { return __builtin_bit_cast(float, __builtin_amdgcn_ds_bpermute(idx << 2, __builtin_bit_cast(int, v))); }
__device__ __forceinline__ void gatomic_add(float* p, float v) { (void)__builtin_amdgcn_global_atomic_fadd_f32((__attribute__((address_space(1))) float*)p, v); }
__device__ __forceinline__ float wave_sum(float v, int lane) {
#pragma unroll
    for (int o = 1; o < 64; o <<= 1) v += shx(v, o, lane);
    return v;
}
__device__ __forceinline__ float wave_sum2(float v, int lane) {
    v += dpp0<0xB1>(v); v += dpp0<0x4E>(v); v += dpp0<0x141>(v); v += dpp0<0x140>(v);
    v += shx(v, 16, lane); v += shx(v, 32, lane);
    return v;
}
namespace pg8 {
#define PG8_LAS __attribute__((address_space(3)))
typedef unsigned short bf16_t;
typedef short bf16x8 __attribute__((ext_vector_type(8)));
typedef float f32x4 __attribute__((ext_vector_type(4)));
typedef unsigned u32x4 __attribute__((ext_vector_type(4)));
constexpr int BM = 256, BK = 64, HALF = 128, HTB = HALF * BK * 2  , STAGE_BYTES = 8 * HTB, NXCD = 8, WGM = 8;

__host__ __device__ __forceinline__ int lds_byte(int r, int c) { const int st = (r >> 4) * 2 + (c >> 5), rr = r & 15, cc = c & 31, ob = rr * 64 + cc * 2; return st * 1024 + (ob ^ (((ob >> 9) & 1) << 5)); }
__host__ __device__ __forceinline__ void stage_rc(int b, int& R, int& C) { const int st = b / 1024, sb = b % 1024, swz = sb ^ (((sb >> 9) & 1) << 5); R = (st >> 1) * 16 + swz / 64; C = (st & 1) * 32 + (swz % 64) / 2; }
__host__ __device__ __forceinline__ int perm32(int rho) { const int n = rho >> 4, i = rho & 15; return 8 * (i >> 2) + 4 * n + (i & 3); }

struct Unit { int pm, pn, k0, nt; };
struct Gemm { const bf16_t* A; const bf16_t* Bt; int M, N, K, wbase, skip; };

struct StaticOrder {
    int nM, nN, nwg, G, c, ntk;
    __host__ __device__ void init(int M, int N, int K, int G_, int c_) { nM = M / BM; nN = N / BM; nwg = nM * nN; G = G_; c = c_; ntk = K / BK; }
    __host__ __device__ bool next(int i, Unit& u) const {
        const long L = (long)i * G + c; if (L >= nwg) return false;
        int wgid = (int)L; { const int q = nwg / NXCD, r = nwg % NXCD, xcd = wgid % NXCD, off = wgid / NXCD; wgid = (xcd < r ? xcd * (q + 1) : r * (q + 1) + (xcd - r) * q) + off; }
        const int nig = WGM * nN, gid = wgid / nig, fm = gid * WGM, gsz = (nM - fm) < WGM ? (nM - fm) : WGM;
        u.pm = fm + ((wgid % nig) % gsz); u.pn = (wgid % nig) / gsz; u.k0 = 0; u.nt = ntk; return true;
    }
    __device__ __forceinline__ void a_ready(const Unit&) const {}
    __device__ __forceinline__ void done(const Unit&) const {}
};

struct SplitOrder {
    int nN, nP, nwg, G, c, nsplit, ntk;
    __host__ __device__ void init(int N, int K, int nsplit_, int G_, int c_) { nN = N / BM; nP = 128 * nN; nsplit = nsplit_; nwg = nP + 2 * nN * nsplit; G = G_; c = c_; ntk = K / BK; }
    __host__ __device__ bool next(int i, Unit& u) const {
        const int L = i * G + c; if (L >= nwg) return false;
        const bool pr = L < nP;
        const int wl = pr ? L : 0, wgid = (wl % NXCD) * (nP / NXCD) + wl / NXCD;
        const int nig = WGM * nN, gid = wgid / nig, rem = wgid % nig;
        const int s = pr ? 0 : L - nP, s2 = s >> 1, ks = s2 / nN, nts = ntk / nsplit;
        const int pm = pr ? gid * WGM + rem % WGM : 128 + (s & 1);
        const int pn = pr ? rem / WGM : s2 % nN;
        const int k0 = pr ? 0 : ks * nts * BK;
        const int nt = pr ? ntk : nts;
        u.pm = pm; u.pn = pn; u.k0 = k0; u.nt = nt;
        return true;
    }
    __device__ __forceinline__ void a_ready(const Unit&) const {}
    __device__ __forceinline__ void done(const Unit&) const {}
};
struct EpiProj {
    static constexpr bool PERM = true, AFTER_DRAIN = false;
    bf16_t* O; int ldc; int half;
    __device__ __forceinline__ void operator()(const f32x4 (&acc)[2][2][4][2], const Unit& u, int wr, int wc, int fr, int fq) const {
        { const int ln = lane_now(); fr = ln & 15; fq = ln >> 4; }
        const int row0 = u.pm * BM + wr * 64 + fr, col0 = u.pn * BM + wc * 32 + 8 * fq;
#pragma unroll
        for (int ai = 0; ai < 2; ++ai)
#pragma unroll
            for (int m = 0; m < 4; ++m) { if (half && ai == 1) continue; bf16_t* rowp = O + (size_t)(row0 + ai * HALF + m * 16) * ldc + col0;
#pragma unroll
                for (int bj = 0; bj < 2; ++bj) { const f32x4 v0 = acc[ai][bj][m][0], v1 = acc[ai][bj][m][1];
                    u32x4 w; w.x = pk2(v0[0], v0[1]); w.y = pk2(v0[2], v0[3]); w.z = pk2(v1[0], v1[1]); w.w = pk2(v1[2], v1[3]);
                    *(u32x4*)(rowp + bj * HALF) = w; } }
    }
};
struct EpiResid {
    static constexpr bool PERM = true, AFTER_DRAIN = false;
    const void* res; void* out; float* slab; int res_bf16, out_bf16;
    __device__ __forceinline__ void operator()(const f32x4 (&acc)[2][2][4][2], const Unit& u, int wr, int wc, int fr, int fq) const {
        { const int ln = lane_now(); fr = ln & 15; fq = ln >> 4; }
        const int row0 = u.pm * BM + wr * 64 + fr, col0 = u.pn * BM + wc * 32 + 8 * fq;
#pragma unroll
        for (int ai = 0; ai < 2; ++ai)
#pragma unroll
            for (int m = 0; m < 4; ++m) { const int row = row0 + ai * HALF + m * 16;
                if (u.pm >= 128) {
                    float* sp = slab + ((size_t)(u.k0 / (u.nt * BK)) * MS + (row - MP)) * DM + col0;
#pragma unroll
                    for (int bj = 0; bj < 2; ++bj)
#pragma unroll
                        for (int n = 0; n < 2; ++n) *(f32x4*)(sp + bj * HALF + 4 * n) = acc[ai][bj][m][n];
                } else {
                    f32x4 rv[2][2];
                    if (res_bf16) { const bf16_t* rp = (const bf16_t*)res + (size_t)row * DM + col0;
#pragma unroll
                        for (int bj = 0; bj < 2; ++bj) { const u32x4 t = *(const u32x4*)(rp + bj * HALF);
                            rv[bj][0] = (f32x4){bf2f(t.x & 0xffffu), bf2f(t.x >> 16), bf2f(t.y & 0xffffu), bf2f(t.y >> 16)}; rv[bj][1] = (f32x4){bf2f(t.z & 0xffffu), bf2f(t.z >> 16), bf2f(t.w & 0xffffu), bf2f(t.w >> 16)}; }
                    } else { const float* rp = (const float*)res + (size_t)row * DM + col0;
#pragma unroll
                        for (int bj = 0; bj < 2; ++bj)
#pragma unroll
                            for (int n = 0; n < 2; ++n) rv[bj][n] = *(const f32x4*)(rp + bj * HALF + 4 * n);
                    }
                    if (out_bf16) { bf16_t* op = (bf16_t*)out + (size_t)row * DM + col0;
#pragma unroll
                        for (int bj = 0; bj < 2; ++bj) { const f32x4 v0 = rv[bj][0] + acc[ai][bj][m][0], v1 = rv[bj][1] + acc[ai][bj][m][1];
                            u32x4 w; w.x = pk2(v0[0], v0[1]); w.y = pk2(v0[2], v0[3]); w.z = pk2(v1[0], v1[1]); w.w = pk2(v1[2], v1[3]); *(u32x4*)(op + bj * HALF) = w; }
                    } else { float* op = (float*)out + (size_t)row * DM + col0;
#pragma unroll
                        for (int bj = 0; bj < 2; ++bj)
#pragma unroll
                            for (int n = 0; n < 2; ++n) *(f32x4*)(op + bj * HALF + 4 * n) = rv[bj][n] + acc[ai][bj][m][n];
                    }
                } }
    }
};
struct EpiUp {
    static constexpr bool PERM = true, AFTER_DRAIN = false;
    bf16_t* G; bf16_t* UH; const float* cw; const float* cb; float* US; int nost;
    __device__ __forceinline__ void operator()(const f32x4 (&acc)[2][2][4][2], const Unit& u, int wr, int wc, int fr, int fq) const {
        { const int ln = lane_now(); fr = ln & 15; fq = ln >> 4; }
        const int jbase = u.pn * 128 + wc * 32 + 8 * fq;
        if (u.pm >= 128) {
            float* sb = US + (size_t)(u.k0 / (u.nt * BK)) * MS * NUP;
#pragma unroll
            for (int ai = 0; ai < 2; ++ai)
#pragma unroll
                for (int m = 0; m < 4; ++m) { __builtin_amdgcn_sched_barrier(0); float* up = sb + (size_t)(u.pm * BM + ai * HALF + wr * 64 + 16 * m + fr - MP) * NUP + jbase;
#pragma unroll
                    for (int n = 0; n < 2; ++n) { *(f32x4*)(up + 4 * n) = acc[ai][0][m][n]; *(f32x4*)(up + DFF + 4 * n) = acc[ai][1][m][n]; } }
            return;
        }
        f32x4 prm[2][8];
#pragma unroll
        for (int n = 0; n < 2; ++n) { const int j = jbase + 4 * n;
            prm[n][0] = *(const f32x4*)(cw + j); prm[n][1] = *(const f32x4*)(cw + NUP + j); prm[n][2] = *(const f32x4*)(cw + 2 * NUP + j); prm[n][3] = *(const f32x4*)(cb + j);
            prm[n][4] = *(const f32x4*)(cw + DFF + j); prm[n][5] = *(const f32x4*)(cw + NUP + DFF + j); prm[n][6] = *(const f32x4*)(cw + 2 * NUP + DFF + j); prm[n][7] = *(const f32x4*)(cb + DFF + j); }
#pragma unroll
        for (int ai = 0; ai < 2; ++ai) {
            const int rowg = u.pm * BM + ai * HALF + wr * 64;
#pragma unroll
            for (int m = 0; m < 4; ++m) {
                __builtin_amdgcn_sched_barrier(0);
                const int r = rowg + 16 * m + fr;
                unsigned pk[4];
#pragma unroll
                for (int n = 0; n < 2; ++n) {
                    const f32x4 w0g = prm[n][0], w1g = prm[n][1], w2g = prm[n][2], bg = prm[n][3], w0v = prm[n][4], w1v = prm[n][5], w2v = prm[n][6], bv = prm[n][7];
                    const f32x4 vg = acc[ai][0][m][n], vv = acc[ai][1][m][n];
                    const f32x4 tg = w1g * vg, sg = w0g * vg, tv = w1v * vv, sv = w0v * vv;
                    f32x4 cg_ = w2g * vg + bg, cv_ = w2v * vv + bv;
#pragma unroll
                    for (int i = 0; i < 4; ++i) {
                        cg_[i] += dpp0<DPP_SHR1>(tg[i] + dpp0<DPP_SHR1>(sg[i]));
                        cv_[i] += dpp0<DPP_SHR1>(tv[i] + dpp0<DPP_SHR1>(sv[i]));
                        if (m > 0) { const float og = acc[ai][0][m > 0 ? m - 1 : 0][n][i], ov = acc[ai][1][m > 0 ? m - 1 : 0][n][i];
                            cg_[i] += dpp0<DPP_SHL15>(w1g[i] * og) + dpp0<DPP_SHL14>(w0g[i] * og); cv_[i] += dpp0<DPP_SHL15>(w1v[i] * ov) + dpp0<DPP_SHL14>(w0v[i] * ov); }
                    }
                    pk[2 * n] = pk2(silu_f(cg_[0]) * cv_[0], silu_f(cg_[1]) * cv_[1]); pk[2 * n + 1] = pk2(silu_f(cg_[2]) * cv_[2], silu_f(cg_[3]) * cv_[3]);
                }
                int slot = -1;
                if (m == 0 && fr < 2) slot = fr; else if (m == 3 && fr >= 14) slot = fr - 12;
                if (slot >= 0 && !(nost & 2)) { bf16_t* up = UH + ((size_t)(r >> 6) * 4 + slot) * NUP + jbase;
                    const f32x4 g0 = acc[ai][0][m][0], g1 = acc[ai][0][m][1], v0 = acc[ai][1][m][0], v1 = acc[ai][1][m][1];
                    u32x4 a, b2; a.x = pk2(g0[0], g0[1]); a.y = pk2(g0[2], g0[3]); a.z = pk2(g1[0], g1[1]); a.w = pk2(g1[2], g1[3]);
                    b2.x = pk2(v0[0], v0[1]); b2.y = pk2(v0[2], v0[3]); b2.z = pk2(v1[0], v1[1]); b2.w = pk2(v1[2], v1[3]);
                    *(u32x4*)up = a; *(u32x4*)(up + DFF) = b2; }
                if (!(m == 0 && fr < 2) && !(nost & 1)) { u32x4 w; w.x = pk[0]; w.y = pk[1]; w.z = pk[2]; w.w = pk[3]; *(u32x4*)(G + (size_t)r * DFF + jbase) = w; }
            }
        }
    }
};
template <class Epi, class Sched, bool STAMP = false>
__device__ __forceinline__ void gemm_phase(PG8_LAS unsigned char* lds, const Gemm g, const Sched& S, const Epi& E, unsigned long long* stamps) {
    const int tid = opaque_tid(g.wbase), wid = __builtin_amdgcn_readfirstlane(tid >> 6), lane = tid & 63, wr = wid >> 2, wc = wid & 3, fr = lane & 15, fq = lane >> 4;
    const int K = g.K;
    int ts_lo = 0, ts_hi = 0, nts = 0; const unsigned long long rt_entry = STAMP ? (unsigned long long)wall_clock64() : 0ull;
#define PG8_STAMP() do { if (STAMP && wid == 0 && nts < 64) { const unsigned long long _c = (unsigned long long)clock64(); \
        ts_lo = (lane == nts) ? (int)(unsigned)_c : ts_lo; ts_hi = (lane == nts) ? (int)(unsigned)(_c >> 32) : ts_hi; ++nts; } } while (0)
    PG8_STAMP();
    unsigned voffA[2], voffB[2];
#pragma unroll
    for (int i = 0; i < 2; ++i) { int R, C; stage_rc(tid * 16 + i * 8192, R, C); const int Rb = Epi::PERM ? ((R & ~31) + perm32(R & 31)) : R;
        voffA[i] = (unsigned)(R * K + C) * 2u; voffB[i] = (unsigned)(Rb * K + C) * 2u; }
    const size_t kstep = (size_t)(BK * 2);
    const size_t hstep = (size_t)HALF * K * 2;
    const size_t tstep = 2 * hstep;
    const unsigned ldsw = (unsigned)wid * 1024u;
    const int aoff = lds_byte(wr * 64 + fr, fq * 8), boff = lds_byte(wc * 32 + fr, fq * 8);
#define PG8_SA(b, h) (((b) * 2 + (h)) * HTB)
#define PG8_SB(b, h) ((4 + (b) * 2 + (h)) * HTB)
#define PG8_STAGE(bufoff, gbase, voff) do { _Pragma("unroll") for (int _i = 0; _i < 2; ++_i) \
        __builtin_amdgcn_global_load_lds((const unsigned*)((const char*)(gbase) + (voff)[_i]), (PG8_LAS unsigned*)(lds + (bufoff) + ldsw + _i * 8192), 16, 0, 0); } while (0)
#define PG8_LDA(dst, b, h) do { _Pragma("unroll") for (int m = 0; m < 4; ++m) _Pragma("unroll") for (int k = 0; k < 2; ++k) dst[m][k] = *(const PG8_LAS bf16x8*)(lds + PG8_SA(b, h) + aoff + m * 2048 + k * 1024); } while (0)
#define PG8_LDB(dst, b, h) do { _Pragma("unroll") for (int n = 0; n < 2; ++n) _Pragma("unroll") for (int k = 0; k < 2; ++k) dst[n][k] = *(const PG8_LAS bf16x8*)(lds + PG8_SB(b, h) + boff + n * 2048 + k * 1024); } while (0)
#define PG8_MMA(ai, bj, At, Bt) do { __builtin_amdgcn_s_setprio(1); _Pragma("unroll") for (int m = 0; m < 4; ++m) _Pragma("unroll") for (int n = 0; n < 2; ++n) _Pragma("unroll") for (int k = 0; k < 2; ++k) \
        acc[ai][bj][m][n] = __builtin_amdgcn_mfma_f32_16x16x32_bf16(Bt[n][k], At[m][k], acc[ai][bj][m][n], 0, 0, 0); __builtin_amdgcn_s_setprio(0); } while (0)
#define PG8_WAIT_V(n) asm volatile("s_waitcnt vmcnt(" #n ")" ::: "memory")
#define PG8_WAIT_L(n) asm volatile("s_waitcnt lgkmcnt(" #n ")" ::: "memory")
#define PG8_BAR __builtin_amdgcn_s_barrier()
#define PG8_SCHED __builtin_amdgcn_sched_barrier(0)
    Unit cur, nxt; int ui = 0;
    if (!S.next(0, cur)) return;
    f32x4 acc[2][2][4][2];
#pragma unroll
    for (int a = 0; a < 2; ++a)
#pragma unroll
        for (int b = 0; b < 2; ++b)
#pragma unroll
            for (int m = 0; m < 4; ++m)
#pragma unroll
                for (int n = 0; n < 2; ++n) acc[a][b][m][n] = (f32x4){0.f, 0.f, 0.f, 0.f};
    bf16x8 At[4][2], B0[2][2], B1[2][2];
    const char* cA = (const char*)g.A + (size_t)cur.pm * tstep + (size_t)cur.k0 * 2; const char* cB = (const char*)g.Bt + (size_t)cur.pn * tstep + (size_t)cur.k0 * 2;
    S.a_ready(cur);
    PG8_STAGE(PG8_SB(0, 0), cB, voffB); PG8_STAGE(PG8_SB(0, 1), cB + hstep, voffB); PG8_STAGE(PG8_SA(0, 0), cA, voffA); PG8_STAGE(PG8_SA(0, 1), cA + hstep, voffA);
    if (wr == 1) PG8_BAR;
    PG8_WAIT_V(2); PG8_BAR;
    PG8_STAGE(PG8_SB(1, 0), cB + kstep, voffB); PG8_STAGE(PG8_SA(1, 0), cA + kstep, voffA); PG8_STAGE(PG8_SB(1, 1), cB + hstep + kstep, voffB);
    PG8_WAIT_V(6); PG8_BAR;
    PG8_STAMP();
    for (;;) {
        const bool has_next = S.next(ui + 1, nxt);
        const char* nA = has_next ? (const char*)g.A + (size_t)nxt.pm * tstep + (size_t)nxt.k0 * 2 : cA; const char* nB = has_next ? (const char*)g.Bt + (size_t)nxt.pn * tstep + (size_t)nxt.k0 * 2 : cB;
        const int nt = cur.nt;
        for (int t = 0; t < nt; t += 2) {
            const bool last = (t == nt - 2);
            const char* a1 = cA + (size_t)(t + 1) * kstep;
            const char* a2 = last ? nA : cA + (size_t)(t + 2) * kstep; const char* b2 = last ? nB : cB + (size_t)(t + 2) * kstep;
            const char* a3 = a2 + kstep; const char* b3 = b2 + kstep;
            if (last && has_next) S.a_ready(nxt);
            PG8_LDB(B0, 0, 0); PG8_LDB(B1, 0, 1); PG8_SCHED; PG8_LDA(At, 0, 0); PG8_STAGE(PG8_SA(1, 1), a1 + hstep, voffA);
            PG8_WAIT_V(8); PG8_WAIT_L(0); PG8_BAR; PG8_MMA(0, 0, At, B0); PG8_MMA(0, 1, At, B1); PG8_BAR; PG8_SCHED;
            PG8_LDA(At, 0, 1); PG8_STAGE(PG8_SB(0, 0), b2, voffB); PG8_STAGE(PG8_SB(0, 1), b2 + hstep, voffB); PG8_STAGE(PG8_SA(0, 0), a2, voffA);
            PG8_WAIT_V(8); PG8_WAIT_L(0); PG8_BAR; PG8_MMA(1, 0, At, B0); PG8_MMA(1, 1, At, B1); PG8_BAR; PG8_SCHED;
            PG8_LDB(B0, 1, 0); PG8_LDB(B1, 1, 1); PG8_SCHED; PG8_LDA(At, 1, 0); PG8_STAGE(PG8_SA(0, 1), a2 + hstep, voffA);
            PG8_WAIT_V(8); PG8_WAIT_L(0); PG8_BAR; PG8_MMA(0, 0, At, B0); PG8_MMA(0, 1, At, B1); PG8_BAR; PG8_SCHED;
            PG8_LDA(At, 1, 1); PG8_STAGE(PG8_SB(1, 0), b3, voffB); PG8_STAGE(PG8_SB(1, 1), b3 + hstep, voffB); PG8_STAGE(PG8_SA(1, 0), a3, voffA);
            PG8_WAIT_V(8); PG8_WAIT_L(0); PG8_BAR; PG8_MMA(1, 0, At, B0); PG8_MMA(1, 1, At, B1); PG8_BAR; PG8_SCHED;
        }
        PG8_STAMP();
        if (wr == 0) PG8_BAR;
        if constexpr (!Epi::AFTER_DRAIN) { if (!g.skip) E(acc, cur, wr, wc, fr, fq); S.done(cur); }
        PG8_STAMP();
        if (!has_next) break;
#pragma unroll
        for (int a = 0; a < 2; ++a)
#pragma unroll
            for (int b = 0; b < 2; ++b)
#pragma unroll
                for (int m = 0; m < 4; ++m)
#pragma unroll
                    for (int n = 0; n < 2; ++n) acc[a][b][m][n] = (f32x4){0.f, 0.f, 0.f, 0.f};
        cur = nxt; cA = nA; cB = nB; ++ui;
        if (wr == 1) PG8_BAR;
    }
    PG8_WAIT_V(0);
    PG8_BAR;
    if constexpr (Epi::AFTER_DRAIN) { E.fused(acc, cur, wr, wc, fr, fq, lds, wid, lane); S.done(cur); }
    PG8_STAMP();
    if (STAMP && wid == 0) { stamps[lane] = lane < nts ? (((unsigned long long)(unsigned)ts_hi << 32) | (unsigned)ts_lo) : 0ull;
        if (lane == 62) stamps[62] = rt_entry; if (lane == 63) stamps[63] = (unsigned long long)wall_clock64(); }
#undef PG8_STAMP
#undef PG8_SA
#undef PG8_SB
#undef PG8_STAGE
#undef PG8_LDA
#undef PG8_LDB
#undef PG8_MMA
#undef PG8_WAIT_V
#undef PG8_WAIT_L
#undef PG8_BAR
#undef PG8_SCHED
}
}

struct Params { const float* in[24]; float* out; unsigned char* ws; int ph_lo, ph_hi, rep, pad; };
enum { I_XP = 0, I_XS, I_SSM, I_SCONV, I_CK, I_CV, I_SFFN, I_N1, I_WIN, I_CW, I_CB, I_DTB, I_ALOG, I_DSKIP, I_SNORM, I_QN, I_KN, I_SINK, I_WOUT, I_N2, I_WUP, I_FCW, I_FCB, I_WDN };

__device__ __forceinline__ void transpose_item(const float* W, int K, int N, int srccol0, bf16_t* WT, int dstrow0, int k0, LAS float* scr, int lane) {
    float tmp[32];
#pragma unroll
    for (int i = 0; i < 32; ++i) tmp[i] = W[(size_t)(k0 + 2 * i + (lane >> 5)) * N + srccol0 + (lane & 31)];
#pragma unroll
    for (int i = 0; i < 32; ++i) scr[(2 * i + (lane >> 5)) * 33 + (lane & 31)] = tmp[i];
    asm volatile("s_waitcnt lgkmcnt(0)" ::: "memory");
    const int c = lane & 7;
#pragma unroll
    for (int j = 0; j < 4; ++j) { const int n = (lane >> 3) + 8 * j; const LAS float* s = scr + (8 * c) * 33 + n;
        u32x4 o; o.x = pk2(s[0 * 33], s[1 * 33]); o.y = pk2(s[2 * 33], s[3 * 33]); o.z = pk2(s[4 * 33], s[5 * 33]); o.w = pk2(s[6 * 33], s[7 * 33]);
        *(u32x4*)(WT + (size_t)(dstrow0 + n) * K + k0 + 8 * c) = o; }
    asm volatile("s_waitcnt lgkmcnt(0)" ::: "memory");
}
__device__ __forceinline__ void phase_weights(const Params& P, LAS unsigned char* lds) {
    const int tid = opaque_tid(P.pad), lane = tid & 63, wave = tid >> 6;
    LAS float* scr = (LAS float*)(lds + wave * 16384);
    const int gw = blockIdx.x * 8 + wave, NGW = gridDim.x * 8;
    constexpr int I_A = 16 * 72, I_B = 16 * 32, I_C = 16 * 176, I_D = 44 * 32, PER = I_A + I_B + I_C + I_D;
    for (int it = gw; it < 2 * PER; it += NGW) {
        const int l = it / PER; int r = it % PER;
        if (r < I_A) { const int kb = r / 72, nb = r % 72, n0 = 32 * nb;
            transpose_item(P.in[I_WIN] + (size_t)l * DM * IN_DIM, DM, IN_DIM, n0 + (n0 >= 1536 ? 8 : 0), (bf16_t*)(P.ws + WS_WIN + l * WIN_L), n0, 64 * kb, scr, lane); continue; }
        r -= I_A;
        if (r < I_B) { const int kb = r / 32, nb = r % 32;
            transpose_item(P.in[I_WOUT] + (size_t)l * DM * DM, DM, DM, 32 * nb, (bf16_t*)(P.ws + WS_WOUT + l * WOUT_L), 32 * nb, 64 * kb, scr, lane); continue; }
        r -= I_B;
        if (r < I_C) { const int kb = r / 176, nb = r % 176, n0 = 32 * nb, pn = n0 >> 8, rem = n0 & 255, bj = rem >> 7, cc = rem & 127;
            transpose_item(P.in[I_WUP] + (size_t)l * DM * NUP, DM, NUP, bj * DFF + pn * 128 + cc, (bf16_t*)(P.ws + WS_WUP + l * WUP_L), n0, 64 * kb, scr, lane); continue; }
        r -= I_C;
        { const int kb = r / 32, nb = r % 32;
            transpose_item(P.in[I_WDN] + (size_t)l * DFF * DM, DFF, DM, 32 * nb, (bf16_t*)(P.ws + WS_WDN + l * WDN_L), 32 * nb, 64 * kb, scr, lane); }
    }
}

template <bool WITH_DT>
__device__ __forceinline__ void phase_norm(const Params& P, LAS unsigned char* lds, int l, const void* xP, int xP_bf16, const float* xS, const float* nw, int nslab) {
    const int tid = opaque_tid(P.pad), lane = tid & 63, wave = tid >> 6;
    bf16_t* HN = (bf16_t*)(P.ws + WS_HN);
    LAS float* WD = (LAS float*)lds;
    if (WITH_DT) {
        const float* win = P.in[I_WIN] + (size_t)l * DM * IN_DIM + 1536;
        for (int e = tid; e < DM * 8; e += 512) WD[(e & 7) * DM + (e >> 3)] = win[(size_t)(e >> 3) * IN_DIM + (e & 7)];
        __syncthreads();
    }
    f32x4 wv[4];
#pragma unroll
    for (int j = 0; j < 2; ++j) { wv[2 * j] = *(const f32x4*)(nw + 8 * lane + 512 * j); wv[2 * j + 1] = *(const f32x4*)(nw + 8 * lane + 512 * j + 4); }
    const int gw = blockIdx.x * 8 + wave, NGW = gridDim.x * 8;
    u32x4 nx[4];
#define NORM_LOAD(dst, r) do { if ((r) < MP && xP_bf16) { const bf16_t* xr_ = (const bf16_t*)xP + (size_t)(r) * DM + 8 * lane; dst[0] = *(const u32x4*)xr_; dst[1] = *(const u32x4*)(xr_ + 512); } \
        else if ((r) < MT) { const float* xr_ = ((r) < MP) ? (const float*)xP + (size_t)(r) * DM + 8 * lane : xS + (size_t)((r) - MP) * DM + 8 * lane; \
            dst[0] = *(const u32x4*)xr_; dst[1] = *(const u32x4*)(xr_ + 4); dst[2] = *(const u32x4*)(xr_ + 512); dst[3] = *(const u32x4*)(xr_ + 516); } } while (0)
    NORM_LOAD(nx, gw);
    for (int row = gw; row < MT; row += NGW) {
        f32x4 v[4]; float s = 0.f;
        u32x4 cu[4];
#pragma unroll
        for (int j = 0; j < 4; ++j) cu[j] = nx[j];
        { const int rn = row + NGW; NORM_LOAD(nx, rn); }
        if (row < MP && xP_bf16) {
#pragma unroll
            for (int j = 0; j < 2; ++j) { v[2 * j] = (f32x4){bf2f(cu[j].x & 0xffffu), bf2f(cu[j].x >> 16), bf2f(cu[j].y & 0xffffu), bf2f(cu[j].y >> 16)};
                v[2 * j + 1] = (f32x4){bf2f(cu[j].z & 0xffffu), bf2f(cu[j].z >> 16), bf2f(cu[j].w & 0xffffu), bf2f(cu[j].w >> 16)}; }
        } else {
#pragma unroll
            for (int j = 0; j < 4; ++j) v[j] = __builtin_bit_cast(f32x4, cu[j]);
        }
        if (row >= MP) {
            const float* sl = (const float*)(P.ws + WS_XSL) + (size_t)(row - MP) * DM + 8 * lane;
            for (int k = 0; k < nslab; ++k)
#pragma unroll
                for (int j = 0; j < 2; ++j) { v[2 * j] = v[2 * j] + *(const f32x4*)(sl + (size_t)k * MS * DM + 512 * j); v[2 * j + 1] = v[2 * j + 1] + *(const f32x4*)(sl + (size_t)k * MS * DM + 512 * j + 4); }
            float* xo = (float*)(P.ws + WS_XS) + (size_t)(row - MP) * DM + 8 * lane;
#pragma unroll
            for (int j = 0; j < 2; ++j) { *(f32x4*)(xo + 512 * j) = v[2 * j]; *(f32x4*)(xo + 512 * j + 4) = v[2 * j + 1]; }
        }
#pragma unroll
        for (int j = 0; j < 4; ++j) s += (v[j][0] * v[j][0] + v[j][1] * v[j][1]) + (v[j][2] * v[j][2] + v[j][3] * v[j][3]);
        const float rstd = rsqrtf(wave_sum2(s, lane) * (1.f / DM) + EPS);
#pragma unroll
        for (int j = 0; j < 4; ++j) v[j] = v[j] * rstd * wv[j];
#pragma unroll
        for (int j = 0; j < 2; ++j) { u32x4 o; o.x = pk2(v[2 * j][0], v[2 * j][1]); o.y = pk2(v[2 * j][2], v[2 * j][3]); o.z = pk2(v[2 * j + 1][0], v[2 * j + 1][1]); o.w = pk2(v[2 * j + 1][2], v[2 * j + 1][3]);
            *(u32x4*)(HN + (size_t)row * DM + 8 * lane + 512 * j) = o; }
        if (WITH_DT) {
            float d[8];
#pragma unroll
            for (int h = 0; h < 8; ++h) d[h] = 0.f;
#pragma unroll
            for (int h = 0; h < 8; ++h)
#pragma unroll
                for (int j = 0; j < 2; ++j) { const f32x4 a = *(const LAS f32x4*)(WD + h * DM + 8 * lane + 512 * j), b = *(const LAS f32x4*)(WD + h * DM + 8 * lane + 512 * j + 4);
                    d[h] += ((v[2 * j][0] * a[0] + v[2 * j][1] * a[1]) + (v[2 * j][2] * a[2] + v[2 * j][3] * a[3])) + ((v[2 * j + 1][0] * b[0] + v[2 * j + 1][1] * b[1]) + (v[2 * j + 1][2] * b[2] + v[2 * j + 1][3] * b[3])); }
#pragma unroll
            for (int h = 0; h < 8; ++h) d[h] = wave_sum2(d[h], lane);
            if (lane < 8) { float dv = d[0];
#pragma unroll
                for (int h = 1; h < 8; ++h) dv = (lane == h) ? d[h] : dv;
                dv += P.in[I_DTB][l * 8 + lane];
                const float e = __expf(-fabsf(dv));
                const float sp = fmaxf(dv, 0.f) + (e < 0.03f ? e * (1.f - e * (0.5f - e * (0.33333333f - 0.25f * e))) : __logf(1.f + e));
                ((float*)(P.ws + WS_DT))[(size_t)row * 8 + lane] = sp; }
        }
    }
#undef NORM_LOAD
}

__device__ __forceinline__ void attn_tile(const u32x4 a, const u32x4 b, const float* qw, const LAS bf16_t* Ks, const LAS bf16_t* VT, int jj0, int relbase, int kmin, int kmax,
                                          float slope, float sink, bf16_t* out, int r, int q) {
    const int lane = r + 16 * q;
    bf16x8 qf[2];
    {
        float x[16];
#pragma unroll
        for (int i = 0; i < 4; ++i) { x[2 * i] = bf2f(a[i] & 0xffffu); x[2 * i + 1] = bf2f(a[i] >> 16); x[8 + 2 * i] = bf2f(b[i] & 0xffffu); x[8 + 2 * i + 1] = bf2f(b[i] >> 16); }
        float ss = 0.f;
#pragma unroll
        for (int i = 0; i < 16; ++i) ss += x[i] * x[i];
        ss += shx(ss, 16, lane); ss += shx(ss, 32, lane);
        const float sc = rsqrtf(ss * (1.f / 64.f) + EPS) * 0.125f;
        const f32x4 w0 = *(const f32x4*)(qw + 8 * q), w1 = *(const f32x4*)(qw + 8 * q + 4), w2 = *(const f32x4*)(qw + 32 + 8 * q), w3 = *(const f32x4*)(qw + 36 + 8 * q);
        const f32x4 a0 = {x[0] * sc * w0[0], x[1] * sc * w0[1], x[2] * sc * w0[2], x[3] * sc * w0[3]}, a1 = {x[4] * sc * w1[0], x[5] * sc * w1[1], x[6] * sc * w1[2], x[7] * sc * w1[3]};
        const f32x4 b0 = {x[8] * sc * w2[0], x[9] * sc * w2[1], x[10] * sc * w2[2], x[11] * sc * w2[3]}, b1 = {x[12] * sc * w3[0], x[13] * sc * w3[1], x[14] * sc * w3[2], x[15] * sc * w3[3]};
        qf[0] = cvt8(a0, a1); qf[1] = cvt8(b0, b1);
    }
    f32x4 s[9];
#pragma unroll
    for (int kt = 0; kt < 9; ++kt) {
        if (kt == 4) __builtin_amdgcn_sched_barrier(0);
        s[kt] = (f32x4){0.f, 0.f, 0.f, 0.f};
#pragma unroll
        for (int ks = 0; ks < 2; ++ks) { const bf16x8 kf = *(const LAS bf16x8*)(Ks + (jj0 + 16 * kt + r) * 72 + 32 * ks + 8 * q);
            s[kt] = __builtin_amdgcn_mfma_f32_16x16x32_bf16(kf, qf[ks], s[kt], 0, 0, 0); }
    }
    __builtin_amdgcn_sched_barrier(0);
    float mx = sink;
#pragma unroll
    for (int kt = 0; kt < 9; ++kt)
#pragma unroll
        for (int j = 0; j < 4; ++j) { const int kl = 16 * kt + 4 * q + j, rel = relbase - kl; const bool valid = (rel >= 0) && (rel < 128) && (kl >= kmin) && (kl < kmax);
            const float v = valid ? s[kt][j] - slope * (float)rel : -1e30f; s[kt][j] = v; mx = fmaxf(mx, v); }
    mx = fmaxf(mx, shx(mx, 16, lane)); mx = fmaxf(mx, shx(mx, 32, lane));
    float den = 0.f;
#pragma unroll
    for (int kt = 0; kt < 9; ++kt)
#pragma unroll
        for (int j = 0; j < 4; ++j) { const float p = (s[kt][j] > -1e29f) ? __expf(s[kt][j] - mx) : 0.f; s[kt][j] = p; den += p; }
    den += shx(den, 16, lane); den += shx(den, 32, lane);
    den += __expf(sink - mx);
    const float inv = 1.f / den;
    __builtin_amdgcn_sched_barrier(0);
    f32x4 o[4];
#pragma unroll
    for (int dt = 0; dt < 4; ++dt) o[dt] = (f32x4){0.f, 0.f, 0.f, 0.f};
#pragma unroll
    for (int kk = 0; kk < 5; ++kk) {
        if (kk == 2) __builtin_amdgcn_sched_barrier(0);
        const f32x4 z4 = {0.f, 0.f, 0.f, 0.f};
        const bf16x8 pf = cvt8(s[2 * kk], (2 * kk + 1 < 9) ? s[2 * kk + 1 < 9 ? 2 * kk + 1 : 8] : z4);
#pragma unroll
        for (int dt = 0; dt < 4; ++dt) {
            const LAS bf16_t* vp = VT + (16 * dt + r) * 264 + jj0 + 32 * kk + 4 * q;
            const u32x2 lo = *(const LAS u32x2*)vp; u32x2 hi = {0u, 0u};
            if (2 * kk + 1 < 9) hi = *(const LAS u32x2*)(vp + 16);
            u32x4 w; w.x = lo.x; w.y = lo.y; w.z = hi.x; w.w = hi.y;
            o[dt] = __builtin_amdgcn_mfma_f32_16x16x32_bf16(__builtin_bit_cast(bf16x8, w), pf, o[dt], 0, 0, 0);
        }
    }
#pragma unroll
    for (int dt = 0; dt < 4; ++dt) { u32x2 w; w.x = pk2(o[dt][0] * inv, o[dt][1] * inv); w.y = pk2(o[dt][2] * inv, o[dt][3] * inv); *(u32x2*)(out + 16 * dt + 4 * q) = w; }
}

__device__ __forceinline__ void ssd_prep_unit(const Params& P, LAS unsigned char* lds, int l, int ci, int g) {
    const int tid = opaque_tid(P.pad), lane = tid & 63, wave = tid >> 6;
    const bf16_t* PROJ = (const bf16_t*)(P.ws + WS_PROJ);
    const float* DT = (const float*)(P.ws + WS_DT);
    float* AC = (float*)(P.ws + WS_AC); float* CD = (float*)(P.ws + WS_CD);
    bf16_t* XTG = (bf16_t*)(P.ws + WS_XTG); bf16_t* BCN = (bf16_t*)(P.ws + WS_BCN); float* ST = (float*)(P.ws + WS_ST);
    LAS bf16_t* XTs = (LAS bf16_t*)lds;
    LAS bf16_t* BT = (LAS bf16_t*)(lds + 69632);
    LAS float* WG = (LAS float*)(lds + 104448);
    const int r0 = ci * 128, c = ci & 63;
    const int cp = tid & 255, th = tid >> 8, lc = 2 * cp;
    int xc; if (lc < 256) xc = g * 256 + lc; else if (lc < 384) xc = 512 + g * 128 + (lc - 256); else xc = 768 + g * 128 + (lc - 384);
    const int t0 = 64 * th;
    const bf16_t* src = PROJ + (size_t)(r0 + t0) * NPROJ + PC_XBC + xc;
    unsigned raw[64];
#pragma unroll
    for (int i = 0; i < 64; ++i) raw[i] = *(const unsigned*)(src + (size_t)i * NPROJ);
    if (wave < 4) {
        const int h = 4 * g + wave; const float a = -__expf(P.in[I_ALOG][l * 8 + h]);
        const float d0 = DT[(size_t)(r0 + lane) * 8 + h], d1 = DT[(size_t)(r0 + 64 + lane) * 8 + h];
        float v0 = d0 * a, v1 = d1 * a;
#pragma unroll
        for (int o = 1; o < 64; o <<= 1) { const int src = lane >= o ? lane - o : lane; const float t0 = shi(v0, src), t1 = shi(v1, src); if (lane >= o) { v0 += t0; v1 += t1; } }
        const float tot0 = shi(v0, 63); v1 += tot0;
        const float last = shi(v1, 63);
        AC[(size_t)(r0 + lane) * 8 + h] = v0; AC[(size_t)(r0 + 64 + lane) * 8 + h] = v1;
        WG[wave * 128 + lane] = __expf(last - v0) * d0; WG[wave * 128 + 64 + lane] = __expf(last - v1) * d1;
        if (lane == 0) CD[ci * 8 + h] = __expf(last);
    }
    __syncthreads();
    {
        const float* cw = P.in[I_CW] + (size_t)l * 4 * 1024 + xc; const float* cb = P.in[I_CB] + (size_t)l * 1024 + xc;
        const f32x2 w0 = *(const f32x2*)cw, w1 = *(const f32x2*)(cw + 1024), w2 = *(const f32x2*)(cw + 2048), w3 = *(const f32x2*)(cw + 3072), bb = *(const f32x2*)cb;
        f32x2 h0 = {0.f, 0.f}, h1 = {0.f, 0.f}, h2 = {0.f, 0.f};
        if (!(c == 0 && th == 0)) {
            const unsigned a = *(const unsigned*)(src - 3 * NPROJ), b = *(const unsigned*)(src - 2 * NPROJ), d = *(const unsigned*)(src - NPROJ);
            h0 = (f32x2){bf2f(a & 0xffffu), bf2f(a >> 16)}; h1 = (f32x2){bf2f(b & 0xffffu), bf2f(b >> 16)}; h2 = (f32x2){bf2f(d & 0xffffu), bf2f(d >> 16)};
        }
        const int hl = lc >> 6;
#pragma unroll
        for (int tb = 0; tb < 8; ++tb) {
            float o0[8], o1[8];
#pragma unroll
            for (int i = 0; i < 8; ++i) {
                const int t = t0 + 8 * tb + i;
                const unsigned a = raw[8 * tb + i];
                const f32x2 cur = {bf2f(a & 0xffffu), bf2f(a >> 16)};
                const f32x2 cv = w0 * h0 + w1 * h1 + w2 * h2 + w3 * cur + bb;
                h0 = h1; h1 = h2; h2 = cur;
                const float y0 = silu_f(cv[0]), y1 = silu_f(cv[1]);
                if (lc < 256) { o0[i] = y0; o1[i] = y1; }
                else { o0[i] = y0; o1[i] = y1; *(unsigned*)(BCN + (size_t)(r0 + t) * 512 + (lc < 384 ? g * 128 + (lc - 256) : 256 + g * 128 + (lc - 384))) = pk2(y0, y1); }
            }
            const int tt = t0 + 8 * tb;
            if (lc < 256) {
                u32x4 u0, u1; u0.x = pk2(o0[0], o0[1]); u0.y = pk2(o0[2], o0[3]); u0.z = pk2(o0[4], o0[5]); u0.w = pk2(o0[6], o0[7]);
                u1.x = pk2(o1[0], o1[1]); u1.y = pk2(o1[2], o1[3]); u1.z = pk2(o1[4], o1[5]); u1.w = pk2(o1[6], o1[7]);
                bf16_t* xg = XTG + ((size_t)ci * 512 + g * 256 + lc) * 128 + tt;
                *(u32x4*)xg = u0; *(u32x4*)(xg + 128) = u1;
                float s0[8], s1[8];
#pragma unroll
                for (int i = 0; i < 8; ++i) { const float w = WG[hl * 128 + tt + i]; s0[i] = o0[i] * w; s1[i] = o1[i] * w; }
                u0.x = pk2(s0[0], s0[1]); u0.y = pk2(s0[2], s0[3]); u0.z = pk2(s0[4], s0[5]); u0.w = pk2(s0[6], s0[7]);
                u1.x = pk2(s1[0], s1[1]); u1.y = pk2(s1[2], s1[3]); u1.z = pk2(s1[4], s1[5]); u1.w = pk2(s1[6], s1[7]);
                *(LAS u32x4*)(XTs + lc * 136 + tt) = u0; *(LAS u32x4*)(XTs + (lc + 1) * 136 + tt) = u1;
            } else if (lc < 384) {
                u32x4 u0, u1; u0.x = pk2(o0[0], o0[1]); u0.y = pk2(o0[2], o0[3]); u0.z = pk2(o0[4], o0[5]); u0.w = pk2(o0[6], o0[7]);
                u1.x = pk2(o1[0], o1[1]); u1.y = pk2(o1[2], o1[3]); u1.z = pk2(o1[4], o1[5]); u1.w = pk2(o1[6], o1[7]);
                *(LAS u32x4*)(BT + (lc - 256) * 136 + tt) = u0; *(LAS u32x4*)(BT + (lc - 255) * 136 + tt) = u1;
            }
        }
        if (c == 63 && th == 1) {
            float* o = P.out + O_PCONV + ((size_t)(l * 4 + (ci >> 6)) * 3) * 1024 + xc;
            *(f32x2*)o = h0; *(f32x2*)(o + 1024) = h1; *(f32x2*)(o + 2048) = h2;
        }
    }
    __syncthreads();
    {
        const int hl = wave >> 1, ph = wave & 1, r = lane & 15, q = lane >> 4;
        f32x4 acc[2][8];
#pragma unroll
        for (int mt = 0; mt < 2; ++mt)
#pragma unroll
            for (int nt = 0; nt < 8; ++nt) acc[mt][nt] = (f32x4){0.f, 0.f, 0.f, 0.f};
#pragma unroll
        for (int ks = 0; ks < 4; ++ks) {
            bf16x8 xf[2];
#pragma unroll
            for (int mt = 0; mt < 2; ++mt) xf[mt] = *(const LAS bf16x8*)(XTs + (hl * 64 + 32 * ph + 16 * mt + r) * 136 + 32 * ks + 8 * q);
#pragma unroll
            for (int nt = 0; nt < 8; ++nt) { const bf16x8 bf = *(const LAS bf16x8*)(BT + (16 * nt + r) * 136 + 32 * ks + 8 * q);
#pragma unroll
                for (int mt = 0; mt < 2; ++mt) acc[mt][nt] = __builtin_amdgcn_mfma_f32_16x16x32_bf16(bf, xf[mt], acc[mt][nt], 0, 0, 0); }
        }
        float* sp = ST + ((size_t)(ci * 8 + 4 * g + hl) * 64) * 128;
#pragma unroll
        for (int mt = 0; mt < 2; ++mt)
#pragma unroll
            for (int nt = 0; nt < 8; ++nt) *(f32x4*)(sp + (size_t)(32 * ph + 16 * mt + r) * 128 + 16 * nt + 4 * q) = acc[mt][nt];
    }
    __syncthreads();
}

__device__ __forceinline__ void attn_prompt_unit(const Params& P, LAS unsigned char* lds, int l, int b, int qb, int kvh) {
    const int tid = opaque_tid(P.pad), lane = tid & 63, wave = tid >> 6;
    const bf16_t* PROJ = (const bf16_t*)(P.ws + WS_PROJ); bf16_t* YCAT = (bf16_t*)(P.ws + WS_YCAT);
    LAS bf16_t* Ks = (LAS bf16_t*)lds;
    LAS bf16_t* VT = (LAS bf16_t*)(lds + 36864);
    const int r1 = b * 8192 + qb * 128;
    u32x4 qa[4], qb4[4];
    {
        const int g = wave >> 1, qh = wave & 1, r = lane & 15, q = lane >> 4, head = kvh * 4 + g;
#pragma unroll
        for (int it = 0; it < 4; ++it) { const bf16_t* qp = PROJ + (size_t)(r1 + 64 * qh + 16 * it + r) * NPROJ + PC_Q + head * 64;
            qa[it] = *(const u32x4*)(qp + 8 * q); qb4[it] = *(const u32x4*)(qp + 32 + 8 * q); }
    }
    {
        const int key = tid >> 1, half = tid & 1; const int row = r1 - 128 + key; const bool ok = (qb > 0) || (key >= 128);
        float kx[32], vx[32];
        if (ok) {
            const bf16_t* kp = PROJ + (size_t)row * NPROJ + PC_K + kvh * 64 + 32 * half; const bf16_t* vp = PROJ + (size_t)row * NPROJ + PC_V + kvh * 64 + 32 * half;
#pragma unroll
            for (int i = 0; i < 4; ++i) { const u32x4 a = *(const u32x4*)(kp + 8 * i), v = *(const u32x4*)(vp + 8 * i);
#pragma unroll
                for (int e = 0; e < 4; ++e) { kx[8 * i + 2 * e] = bf2f(a[e] & 0xffffu); kx[8 * i + 2 * e + 1] = bf2f(a[e] >> 16); vx[8 * i + 2 * e] = bf2f(v[e] & 0xffffu); vx[8 * i + 2 * e + 1] = bf2f(v[e] >> 16); } }
        } else {
#pragma unroll
            for (int i = 0; i < 32; ++i) { kx[i] = 0.f; vx[i] = 0.f; }
        }
        float ss = 0.f;
#pragma unroll
        for (int i = 0; i < 32; ++i) ss += kx[i] * kx[i];
        ss += shx(ss, 1, lane);
        const float rs = rsqrtf(ss * (1.f / 64.f) + EPS);
        const float* kw = P.in[I_KN] + l * 64 + 32 * half;
#pragma unroll
        for (int i = 0; i < 32; ++i) kx[i] = kx[i] * rs * kw[i];
#pragma unroll
        for (int i = 0; i < 4; ++i) { u32x4 w; w.x = pk2(kx[8 * i], kx[8 * i + 1]); w.y = pk2(kx[8 * i + 2], kx[8 * i + 3]); w.z = pk2(kx[8 * i + 4], kx[8 * i + 5]); w.w = pk2(kx[8 * i + 6], kx[8 * i + 7]);
            *(LAS u32x4*)(Ks + key * 72 + 32 * half + 8 * i) = w; }
#pragma unroll
        for (int i = 0; i < 32; ++i) VT[(32 * half + i) * 264 + key] = (bf16_t)(pk2(vx[i], 0.f) & 0xffffu);
        if (qb == 63 && key >= 128) {
            float* ko = P.out + O_PK + (((size_t)(l * 4 + b) * 128 + (key - 128)) * 2 + kvh) * 64 + 32 * half; float* vo = P.out + O_PV + (((size_t)(l * 4 + b) * 128 + (key - 128)) * 2 + kvh) * 64 + 32 * half;
#pragma unroll
            for (int i = 0; i < 8; ++i) { *(f32x4*)(ko + 4 * i) = (f32x4){kx[4 * i], kx[4 * i + 1], kx[4 * i + 2], kx[4 * i + 3]}; *(f32x4*)(vo + 4 * i) = (f32x4){vx[4 * i], vx[4 * i + 1], vx[4 * i + 2], vx[4 * i + 3]}; }
        }
    }
    __syncthreads();
    {
        const int g = wave >> 1, qh = wave & 1, r = lane & 15, q = lane >> 4, head = kvh * 4 + g;
        const float slope = exp2f(-(float)(head + 1)), sink = P.in[I_SINK][l * 8 + head];
#pragma unroll
        for (int it = 0; it < 4; ++it) {
            const int i0 = 64 * qh + 16 * it; const int row = r1 + i0 + r;
            __builtin_amdgcn_sched_barrier(0);
            attn_tile(qa[it], qb4[it], P.in[I_QN] + l * 64, Ks, VT, i0, r + 128, (qb > 0) ? 0 : 128 - i0, 144, slope, sink,
                      YCAT + (size_t)row * DM + 512 + head * 64, r, q);
        }
    }
    __syncthreads();
}

__device__ __forceinline__ void ssd_sample_unit(const Params& P, LAS unsigned char* lds, int l, int b, int g) {
    const int tid = opaque_tid(P.pad);
    const bf16_t* PROJ = (const bf16_t*)(P.ws + WS_PROJ); const float* DT = (const float*)(P.ws + WS_DT); bf16_t* YCAT = (bf16_t*)(P.ws + WS_YCAT);
    LAS float* XV = (LAS float*)lds;
    LAS float* YZ = (LAS float*)(lds + 8192);
    LAS float* RS = (LAS float*)(lds + 12288);
    const int rs0 = MP + 4 * b;
    {
        const int lc = tid; int xc; if (lc < 256) xc = g * 256 + lc; else if (lc < 384) xc = 512 + g * 128 + (lc - 256); else xc = 768 + g * 128 + (lc - 384);
        const float* cw = P.in[I_CW] + (size_t)l * 4 * 1024 + xc; const float w0 = cw[0], w1 = cw[1024], w2 = cw[2048], w3 = cw[3072], bb = P.in[I_CB][l * 1024 + xc];
        const float* sp = P.in[I_SCONV] + ((size_t)(l * 128 + b) * 3) * 1024 + xc;
        float h0 = sp[0], h1 = sp[1024], h2 = sp[2048];
#pragma unroll
        for (int t = 0; t < 4; ++t) {
            const float cur = bf2f(PROJ[(size_t)(rs0 + t) * NPROJ + PC_XBC + xc]);
            const float cv = w0 * h0 + w1 * h1 + w2 * h2 + w3 * cur + bb;
            h0 = h1; h1 = h2; h2 = cur;
            XV[t * 512 + lc] = silu_f(cv);
        }
        float* o = P.out + O_SCONV + ((size_t)(l * 128 + b) * 3) * 1024 + xc; o[0] = h0; o[1024] = h1; o[2048] = h2;
    }
    __syncthreads();
    {
        const int hl = tid >> 7, p = (tid & 127) >> 1, nh = tid & 1, h = 4 * g + hl, lane = tid & 63;
        const float a = -__expf(P.in[I_ALOG][l * 8 + h]), dsk = P.in[I_DSKIP][l * 8 + h];
        const float* sin_ = P.in[I_SSM] + (((size_t)(l * 128 + b) * 8 + h) * 64 + p) * 128 + 64 * nh;
        float* sout = P.out + O_SSSM + (((size_t)(l * 128 + b) * 8 + h) * 64 + p) * 128 + 64 * nh;
        f32x4 st[16];
#pragma unroll
        for (int i = 0; i < 16; ++i) st[i] = *(const f32x4*)(sin_ + 4 * i);
        float dtv[4], zv[4];
#pragma unroll
        for (int t = 0; t < 4; ++t) { dtv[t] = DT[(size_t)(rs0 + t) * 8 + h]; zv[t] = bf2f(PROJ[(size_t)(rs0 + t) * NPROJ + PC_Z + h * 64 + p]); }
#pragma unroll
        for (int t = 0; t < 4; ++t) {
            const float dt = dtv[t], dA = __expf(dt * a), x = XV[t * 512 + hl * 64 + p], xdt = x * dt;
            float y = 0.f;
#pragma unroll
            for (int i = 0; i < 16; ++i) { const f32x4 bv = *(const LAS f32x4*)(XV + t * 512 + 256 + 64 * nh + 4 * i), cv = *(const LAS f32x4*)(XV + t * 512 + 384 + 64 * nh + 4 * i);
                st[i] = st[i] * dA + xdt * bv; y += (st[i][0] * cv[0] + st[i][1] * cv[1]) + (st[i][2] * cv[2] + st[i][3] * cv[3]); }
            y += shx(y, 1, lane);
            y += dsk * x;
            const float z = zv[t];
            if (nh == 0) YZ[t * 256 + hl * 64 + p] = y * silu_f(z);
        }
#pragma unroll
        for (int i = 0; i < 16; ++i) *(f32x4*)(sout + 4 * i) = st[i];
    }
    __syncthreads();
    {
        const int wave = tid >> 6, lane = tid & 63;
        if (wave < 4) { float s = 0.f;
#pragma unroll
            for (int i = 0; i < 4; ++i) { const float v = YZ[wave * 256 + lane + 64 * i]; s += v * v; }
            s = wave_sum(s, lane); if (lane == 0) RS[wave] = rsqrtf(s * (1.f / 256.f) + EPS); }
    }
    __syncthreads();
    for (int e = tid; e < 1024; e += 512) { const int t = e >> 8, ch = e & 255;
        YCAT[(size_t)(rs0 + t) * DM + g * 256 + ch] = (bf16_t)(pk2(YZ[e] * RS[t] * P.in[I_SNORM][l * 512 + g * 256 + ch], 0.f) & 0xffffu); }
    __syncthreads();
}

__device__ __forceinline__ void attn_sample_unit(const Params& P, LAS unsigned char* lds, int l, int b, int kvh) {
    const int tid = opaque_tid(P.pad), lane = tid & 63, wave = tid >> 6;
    const bf16_t* PROJ = (const bf16_t*)(P.ws + WS_PROJ); bf16_t* YCAT = (bf16_t*)(P.ws + WS_YCAT);
    LAS bf16_t* Ks = (LAS bf16_t*)lds; LAS bf16_t* VT = (LAS bf16_t*)(lds + 36864);
    const int rs0 = MP + 4 * b;
    {
        const int key = tid >> 2, qt = tid & 3;
        const float* kp = P.in[I_CK] + (((size_t)(l * 128 + b) * 128 + key) * 2 + kvh) * 64 + 16 * qt; const float* vp = P.in[I_CV] + (((size_t)(l * 128 + b) * 128 + key) * 2 + kvh) * 64 + 16 * qt;
        f32x4 k4[4], v4[4];
#pragma unroll
        for (int i = 0; i < 4; ++i) { k4[i] = *(const f32x4*)(kp + 4 * i); v4[i] = *(const f32x4*)(vp + 4 * i); }
        *(LAS u32x4*)(Ks + key * 72 + 16 * qt) = __builtin_bit_cast(u32x4, cvt8(k4[0], k4[1])); *(LAS u32x4*)(Ks + key * 72 + 16 * qt + 8) = __builtin_bit_cast(u32x4, cvt8(k4[2], k4[3]));
#pragma unroll
        for (int i = 0; i < 4; ++i)
#pragma unroll
            for (int e = 0; e < 4; ++e) VT[(16 * qt + 4 * i + e) * 264 + key] = (bf16_t)(pk2(v4[i][e], 0.f) & 0xffffu);
        if (key >= 4) {
            float* ko = P.out + O_SK + (((size_t)(l * 128 + b) * 128 + (key - 4)) * 2 + kvh) * 64 + 16 * qt; float* vo = P.out + O_SV + (((size_t)(l * 128 + b) * 128 + (key - 4)) * 2 + kvh) * 64 + 16 * qt;
#pragma unroll
            for (int i = 0; i < 4; ++i) { *(f32x4*)(ko + 4 * i) = k4[i]; *(f32x4*)(vo + 4 * i) = v4[i]; }
        }
    }
    if (tid < 64) {
        const int t = tid >> 4, d4 = (tid & 15) * 4;
        const bf16_t* kp = PROJ + (size_t)(rs0 + t) * NPROJ + PC_K + kvh * 64 + d4; const bf16_t* vp = PROJ + (size_t)(rs0 + t) * NPROJ + PC_V + kvh * 64 + d4;
        const u32x2 a = *(const u32x2*)kp, v = *(const u32x2*)vp;
        float kx[4] = {bf2f(a.x & 0xffffu), bf2f(a.x >> 16), bf2f(a.y & 0xffffu), bf2f(a.y >> 16)}, vx[4] = {bf2f(v.x & 0xffffu), bf2f(v.x >> 16), bf2f(v.y & 0xffffu), bf2f(v.y >> 16)};
        float ss = (kx[0] * kx[0] + kx[1] * kx[1]) + (kx[2] * kx[2] + kx[3] * kx[3]);
        ss += shx(ss, 1, lane); ss += shx(ss, 2, lane); ss += shx(ss, 4, lane); ss += shx(ss, 8, lane);
        const float rs = rsqrtf(ss * (1.f / 64.f) + EPS);
        const f32x4 kw = *(const f32x4*)(P.in[I_KN] + l * 64 + d4);
#pragma unroll
        for (int e = 0; e < 4; ++e) kx[e] = kx[e] * rs * kw[e];
        u32x2 w; w.x = pk2(kx[0], kx[1]); w.y = pk2(kx[2], kx[3]); *(LAS u32x2*)(Ks + (128 + t) * 72 + d4) = w;
#pragma unroll
        for (int e = 0; e < 4; ++e) VT[(d4 + e) * 264 + 128 + t] = (bf16_t)(pk2(vx[e], 0.f) & 0xffffu);
        float* ko = P.out + O_SK + (((size_t)(l * 128 + b) * 128 + (124 + t)) * 2 + kvh) * 64 + d4; float* vo = P.out + O_SV + (((size_t)(l * 128 + b) * 128 + (124 + t)) * 2 + kvh) * 64 + d4;
        *(f32x4*)ko = (f32x4){kx[0], kx[1], kx[2], kx[3]}; *(f32x4*)vo = (f32x4){vx[0], vx[1], vx[2], vx[3]};
    } else if (tid < 128) {
        const int e = tid - 64;
        for (int i = e; i < 12 * 64; i += 64) Ks[(132 + i / 64) * 72 + (i & 63)] = 0;
        for (int i = e; i < 64 * 12; i += 64) VT[(i / 12) * 264 + 132 + (i % 12)] = 0;
    }
    __syncthreads();
    if (wave == 0) {
        const int r = lane & 15, q = lane >> 4, g = r >> 2, t = r & 3, head = kvh * 4 + g;
        const float slope = exp2f(-(float)(head + 1)), sink = P.in[I_SINK][l * 8 + head];
        const bf16_t* qp = PROJ + (size_t)(rs0 + t) * NPROJ + PC_Q + head * 64;
        attn_tile(*(const u32x4*)(qp + 8 * q), *(const u32x4*)(qp + 32 + 8 * q), P.in[I_QN] + l * 64, Ks, VT, 0, t + 128, 0, 132, slope, sink,
                  YCAT + (size_t)(rs0 + t) * DM + 512 + head * 64, r, q);
    }
    __syncthreads();
}

__device__ __forceinline__ void phase_scan(const Params& P, int l) {
    const float* ST = (const float*)(P.ws + WS_ST); const float* CD = (const float*)(P.ws + WS_CD); bf16_t* PB = (bf16_t*)(P.ws + WS_PSTB);
    for (int idx = blockIdx.x * 512 + opaque_tid(P.pad); idx < 131072; idx += gridDim.x * 512) {
        const int b = idx >> 15, rem = idx & 32767, h = rem >> 12, e2 = rem & 4095;
        f32x2 carry = {0.f, 0.f};
        for (int c0 = 0; c0 < 64; c0 += 16) {
            f32x2 v[16]; float dc[16];
#pragma unroll
            for (int i = 0; i < 16; ++i) { v[i] = *(const f32x2*)(ST + ((size_t)((b * 64 + c0 + i) * 8 + h)) * 8192 + 2 * e2); dc[i] = CD[(b * 64 + c0 + i) * 8 + h]; }
#pragma unroll
            for (int i = 0; i < 16; ++i) { *(unsigned*)(PB + ((size_t)((b * 64 + c0 + i) * 8 + h)) * 8192 + 2 * e2) = pk2(carry[0], carry[1]); carry = carry * dc[i] + v[i]; }
        }
        *(f32x2*)(P.out + O_PSSM + ((size_t)((l * 4 + b) * 8 + h)) * 8192 + 2 * e2) = carry;
    }
}

__device__ __forceinline__ void ssd_out_unit(const Params& P, LAS unsigned char* lds, int l, int ci, int g) {
    const int tid = opaque_tid(P.pad), lane = tid & 63, wave = tid >> 6;
    const bf16_t* PROJ = (const bf16_t*)(P.ws + WS_PROJ); const float* DT = (const float*)(P.ws + WS_DT); const float* AC = (const float*)(P.ws + WS_AC);
    const bf16_t* XTG = (const bf16_t*)(P.ws + WS_XTG); const bf16_t* BCN = (const bf16_t*)(P.ws + WS_BCN); const bf16_t* PB = (const bf16_t*)(P.ws + WS_PSTB);
    bf16_t* YCAT = (bf16_t*)(P.ws + WS_YCAT);
    LAS bf16_t* XT = (LAS bf16_t*)lds;
    LAS bf16_t* Bn = (LAS bf16_t*)(lds + 69632);
    LAS bf16_t* Cn = (LAS bf16_t*)(lds + 104448);
    LAS float* ACs = (LAS float*)(lds + 139264);
    LAS float* DTs = (LAS float*)(lds + 141312);
    const int r0 = ci * 128;
    for (int e = tid; e < 4096; e += 512) { const int row = e >> 4, pc = e & 15; *(LAS u32x4*)(XT + row * 136 + 8 * pc) = *(const u32x4*)(XTG + ((size_t)ci * 512 + g * 256 + row) * 128 + 8 * pc); }
    for (int e = tid; e < 2048; e += 512) { const int row = e >> 4, pc = e & 15;
        *(LAS u32x4*)(Bn + row * 136 + 8 * pc) = *(const u32x4*)(BCN + (size_t)(r0 + row) * 512 + g * 128 + 8 * pc);
        *(LAS u32x4*)(Cn + row * 136 + 8 * pc) = *(const u32x4*)(BCN + (size_t)(r0 + row) * 512 + 256 + g * 128 + 8 * pc); }
    { const int hl = tid >> 7, t = tid & 127; ACs[hl * 128 + t] = AC[(size_t)(r0 + t) * 8 + 4 * g + hl]; DTs[hl * 128 + t] = DT[(size_t)(r0 + t) * 8 + 4 * g + hl]; }
    __syncthreads();
    {
        const int r = lane & 15, q = lane >> 4;
        bf16x8 cf2[2][4]; f32x4 gt2[2][8];
#pragma unroll
        for (int half = 0; half < 2; ++half) {
            const int nt = half == 0 ? wave : 7 - wave, lrow = 16 * nt + r;
#pragma unroll
            for (int ks = 0; ks < 4; ++ks) cf2[half][ks] = *(const LAS bf16x8*)(Cn + lrow * 136 + 32 * ks + 8 * q);
#pragma unroll
            for (int st = 0; st < 8; ++st) {
                gt2[half][st] = (f32x4){0.f, 0.f, 0.f, 0.f};
                if ((st & 1) == 0) __builtin_amdgcn_sched_barrier(0);
                if (st <= nt) {
#pragma unroll
                    for (int ks = 0; ks < 4; ++ks) gt2[half][st] = __builtin_amdgcn_mfma_f32_16x16x32_bf16(*(const LAS bf16x8*)(Bn + (16 * st + r) * 136 + 32 * ks + 8 * q), cf2[half][ks], gt2[half][st], 0, 0, 0);
                }
            }
        }
        float ss = 0.f;
        __syncthreads();
        LAS bf16_t* YL = (LAS bf16_t*)(lds + 69632);
#pragma unroll
        for (int half = 0; half < 2; ++half) {
        const int nt = half == 0 ? wave : 7 - wave, lrow = 16 * nt + r, grow = r0 + lrow;
        const bf16x8 (&cf)[4] = cf2[half]; const f32x4 (&gt)[8] = gt2[half];
#pragma unroll 1
        for (int hh = 0; hh < 2; ++hh) {
            const int hl = 2 * half + hh, h = 4 * g + hl;
            __builtin_amdgcn_sched_barrier(0);
            f32x4 acc[4], aco[4];
#pragma unroll
            for (int mt = 0; mt < 4; ++mt) { acc[mt] = (f32x4){0.f, 0.f, 0.f, 0.f}; aco[mt] = (f32x4){0.f, 0.f, 0.f, 0.f}; }
            const bf16_t* pv = PB + ((size_t)(ci * 8 + h) * 64) * 128;
            bf16x8 pf[2][4];
#pragma unroll
            for (int ks = 0; ks < 2; ++ks)
#pragma unroll
                for (int mt = 0; mt < 4; ++mt) pf[ks][mt] = *(const bf16x8*)(pv + (size_t)(16 * mt + r) * 128 + 32 * ks + 8 * q);
            u32x2 zzv[4];
#pragma unroll
            for (int mt = 0; mt < 4; ++mt) zzv[mt] = *(const u32x2*)(PROJ + (size_t)grow * NPROJ + PC_Z + h * 64 + 16 * mt + 4 * q);
            const float dsk = P.in[I_DSKIP][l * 8 + h];
            const float al = ACs[hl * 128 + lrow], el = __expf(al);
#pragma unroll
            for (int kk = 0; kk < 4; ++kk) {
                __builtin_amdgcn_sched_barrier(0);
                if (kk == 2) {
#pragma unroll
                    for (int ks = 0; ks < 2; ++ks)
#pragma unroll
                        for (int mt = 0; mt < 4; ++mt) aco[mt] = __builtin_amdgcn_mfma_f32_16x16x32_bf16(pf[ks][mt], cf[ks], aco[mt], 0, 0, 0);
#pragma unroll
                    for (int ks = 0; ks < 2; ++ks)
#pragma unroll
                        for (int mt = 0; mt < 4; ++mt) pf[ks][mt] = *(const bf16x8*)(pv + (size_t)(16 * mt + r) * 128 + 32 * (ks + 2) + 8 * q);
                    __builtin_amdgcn_sched_barrier(0);
                }
                if (2 * kk <= nt) {
                    f32x4 wv[2];
#pragma unroll
                    for (int hf = 0; hf < 2; ++hf) { const int st = 2 * kk + hf;
                        const f32x4 as = *(const LAS f32x4*)(ACs + hl * 128 + 16 * st + 4 * q), ds = *(const LAS f32x4*)(DTs + hl * 128 + 16 * st + 4 * q);
#pragma unroll
                        for (int j = 0; j < 4; ++j) { const int s = 16 * st + 4 * q + j; wv[hf][j] = (s <= lrow) ? gt[st][j] * __expf(al - as[j]) * ds[j] : 0.f; } }
                    const bf16x8 wf = cvt8(wv[0], wv[1]);
#pragma unroll
                    for (int mt = 0; mt < 4; ++mt) { const LAS bf16_t* xp = XT + (hl * 64 + 16 * mt + r) * 136 + 32 * kk + 4 * q;
                        const u32x2 lo = *(const LAS u32x2*)xp, hi = *(const LAS u32x2*)(xp + 16); u32x4 w; w.x = lo.x; w.y = lo.y; w.z = hi.x; w.w = hi.y;
                        acc[mt] = __builtin_amdgcn_mfma_f32_16x16x32_bf16(__builtin_bit_cast(bf16x8, w), wf, acc[mt], 0, 0, 0); }
                }
            }
            __builtin_amdgcn_sched_barrier(0);
#pragma unroll
            for (int ks = 0; ks < 2; ++ks)
#pragma unroll
                for (int mt = 0; mt < 4; ++mt) aco[mt] = __builtin_amdgcn_mfma_f32_16x16x32_bf16(pf[ks][mt], cf[ks + 2], aco[mt], 0, 0, 0);
#pragma unroll
            for (int mt = 0; mt < 4; ++mt) acc[mt] = acc[mt] + aco[mt] * el;
#pragma unroll
            for (int mt = 0; mt < 4; ++mt) { const u32x2 zz = zzv[mt];
                const float z[4] = {bf2f(zz.x & 0xffffu), bf2f(zz.x >> 16), bf2f(zz.y & 0xffffu), bf2f(zz.y >> 16)};
                float yv[4];
#pragma unroll
                for (int j = 0; j < 4; ++j) { const float x = bf2f(XT[(hl * 64 + 16 * mt + 4 * q + j) * 136 + lrow]); const float y = (acc[mt][j] + dsk * x) * silu_f(z[j]); yv[j] = y; ss += y * y; }
                u32x2 yo; yo.x = pk2(yv[0], yv[1]); yo.y = pk2(yv[2], yv[3]); *(LAS u32x2*)(YL + lrow * 264 + hl * 64 + 16 * mt + 4 * q) = yo; }
        }
        }
        (void)ss;
        __syncthreads();
        const int nt = wave;
        const float* nw = P.in[I_SNORM] + l * 512 + g * 256;
        const int piece = lane & 31, rsub = lane >> 5;
        const f32x4 w0 = *(const f32x4*)(nw + 8 * piece), w1 = *(const f32x4*)(nw + 8 * piece + 4);
#pragma unroll
        for (int ps = 0; ps < 8; ++ps) {
            const int rr = 2 * ps + rsub;
            const u32x4 yv = *(const LAS u32x4*)(YL + (16 * nt + rr) * 264 + 8 * piece);
            const float y0 = bf2f(yv.x & 0xffffu), y1 = bf2f(yv.x >> 16), y2 = bf2f(yv.y & 0xffffu), y3 = bf2f(yv.y >> 16), y4 = bf2f(yv.z & 0xffffu), y5 = bf2f(yv.z >> 16), y6 = bf2f(yv.w & 0xffffu), y7 = bf2f(yv.w >> 16);
            float sq = ((y0 * y0 + y1 * y1) + (y2 * y2 + y3 * y3)) + ((y4 * y4 + y5 * y5) + (y6 * y6 + y7 * y7));
            sq += dpp0<0xB1>(sq); sq += dpp0<0x4E>(sq); sq += dpp0<0x141>(sq); sq += dpp0<0x140>(sq); sq += shx(sq, 16, lane);
            const float rs = rsqrtf(sq * (1.f / 256.f) + EPS);
            u32x4 o; o.x = pk2(y0 * rs * w0[0], y1 * rs * w0[1]); o.y = pk2(y2 * rs * w0[2], y3 * rs * w0[3]);
            o.z = pk2(y4 * rs * w1[0], y5 * rs * w1[1]); o.w = pk2(y6 * rs * w1[2], y7 * rs * w1[3]);
            *(u32x4*)(YCAT + (size_t)(r0 + 16 * nt + rr) * DM + g * 256 + 8 * piece) = o;
        }
    }
    __syncthreads();
}

__device__ __forceinline__ void phase_fixup(const Params& P, int l) {
    const bf16_t* UH = (const bf16_t*)(P.ws + WS_UH); bf16_t* G = (bf16_t*)(P.ws + WS_G);
    const float* cw = P.in[I_FCW] + (size_t)l * 3 * NUP; const float* cb = P.in[I_FCB] + (size_t)l * NUP;
    for (int gi = blockIdx.x; gi < 512; gi += gridDim.x) {
        const bool first = (gi & 127) == 0;
        const bf16_t* cur = UH + (size_t)gi * 4 * NUP; const bf16_t* prv = UH + (size_t)(gi - 1) * 4 * NUP;
        for (int j4 = opaque_tid(P.pad); j4 < DFF / 4; j4 += 512) {
            const int j = 4 * j4;
            f32x4 cvv[2][2];
#pragma unroll
            for (int gv = 0; gv < 2; ++gv) { const int c = j + gv * DFF;
                const f32x4 w0 = *(const f32x4*)(cw + c), w1 = *(const f32x4*)(cw + NUP + c), w2 = *(const f32x4*)(cw + 2 * NUP + c), bb = *(const f32x4*)(cb + c);
                const u32x2 a0 = *(const u32x2*)(cur + c), a1 = *(const u32x2*)(cur + NUP + c);
                u32x2 p2 = {0u, 0u}, p1 = {0u, 0u}; if (!first) { p2 = *(const u32x2*)(prv + 2 * NUP + c); p1 = *(const u32x2*)(prv + 3 * NUP + c); }
                const f32x4 u0 = {bf2f(a0.x & 0xffffu), bf2f(a0.x >> 16), bf2f(a0.y & 0xffffu), bf2f(a0.y >> 16)}, u1 = {bf2f(a1.x & 0xffffu), bf2f(a1.x >> 16), bf2f(a1.y & 0xffffu), bf2f(a1.y >> 16)};
                const f32x4 pm2 = {bf2f(p2.x & 0xffffu), bf2f(p2.x >> 16), bf2f(p2.y & 0xffffu), bf2f(p2.y >> 16)}, pm1 = {bf2f(p1.x & 0xffffu), bf2f(p1.x >> 16), bf2f(p1.y & 0xffffu), bf2f(p1.y >> 16)};
                cvv[0][gv] = w0 * pm2 + w1 * pm1 + w2 * u0 + bb; cvv[1][gv] = w0 * pm1 + w1 * u0 + w2 * u1 + bb; }
#pragma unroll
            for (int rr = 0; rr < 2; ++rr) { u32x2 o; o.x = pk2(silu_f(cvv[rr][0][0]) * cvv[rr][1][0], silu_f(cvv[rr][0][1]) * cvv[rr][1][1]); o.y = pk2(silu_f(cvv[rr][0][2]) * cvv[rr][1][2], silu_f(cvv[rr][0][3]) * cvv[rr][1][3]);
                *(u32x2*)(G + (size_t)(64 * gi + rr) * DFF + j) = o; }
        }
        if ((gi & 127) == 127) { float* o = P.out + O_PFFN + ((size_t)(l * 4 + (gi >> 7)) * 2) * NUP;
            for (int c = opaque_tid(P.pad); c < 2 * NUP; c += 512) o[c] = bf2f(cur[2 * NUP + c]); }
    }
    const float* US = (const float*)(P.ws + WS_US);
    for (int hb = blockIdx.x; hb < 256; hb += gridDim.x) {
        const int b = hb >> 1, jlo = (hb & 1) * (DFF / 2);
        const float* sp = P.in[I_SFFN] + ((size_t)(l * 128 + b) * 2) * NUP; float* sn = P.out + O_SFFN + ((size_t)(l * 128 + b) * 2) * NUP;
        const float* ub = US + (size_t)(4 * b) * NUP;
        for (int j = jlo + opaque_tid(P.pad); j < jlo + DFF / 2; j += 512) {
            float cv[4][2];
#pragma unroll
            for (int gv = 0; gv < 2; ++gv) { const int c = j + gv * DFF;
                const float w0 = cw[c], w1 = cw[NUP + c], w2 = cw[2 * NUP + c], bb = cb[c];
                const float s0 = sp[c], s1 = sp[NUP + c]; float u0 = 0.f, u1 = 0.f, u2 = 0.f, u3 = 0.f;
#pragma unroll
                for (int k = 0; k < 4; ++k) { const float* uk = ub + (size_t)k * MS * NUP; u0 += uk[c]; u1 += uk[NUP + c]; u2 += uk[2 * NUP + c]; u3 += uk[3 * NUP + c]; }
                cv[0][gv] = w0 * s0 + w1 * s1 + w2 * u0 + bb; cv[1][gv] = w0 * s1 + w1 * u0 + w2 * u1 + bb;
                cv[2][gv] = w0 * u0 + w1 * u1 + w2 * u2 + bb; cv[3][gv] = w0 * u1 + w1 * u2 + w2 * u3 + bb;
                sn[c] = u2; sn[NUP + c] = u3; }
#pragma unroll
            for (int t = 0; t < 4; ++t) G[(size_t)(MP + 4 * b + t) * DFF + j] = (bf16_t)(pk2(silu_f(cv[t][0]) * cv[t][1], 0.f) & 0xffffu);
        }
    }
}

__device__ __forceinline__ void phase_final(const Params& P) {
    const int tid = opaque_tid(P.pad);
    for (int i = blockIdx.x * 512 + tid; i < MS * DM / 4; i += gridDim.x * 512) {
        f32x4 v = *(const f32x4*)((const float*)(P.ws + WS_XS) + 4 * i);
        for (int k = 0; k < 11; ++k) v = v + *(const f32x4*)((const float*)(P.ws + WS_XSL) + (size_t)k * MS * DM + 4 * i);
        *(f32x4*)(P.out + (size_t)MP * DM + 4 * i) = v;
    }
}
#define XB_TMO      128
#define XB_XCNT(j)  (256  + 64 * (j))
#define XB_XSUB(j)  (1280 + 64 * (j))
#define XB_XGEN(j)  (2304 + 64 * (j))
#define XB_TOP      3328
#define XB_TOPGEN   3392
#define XCD_BAR_WORDS 3456
#define XB_SPIN_CAP (1u << 18)


__device__ __forceinline__ unsigned xb_ld(unsigned* p)              { return __hip_atomic_load(p, __ATOMIC_RELAXED, __HIP_MEMORY_SCOPE_AGENT); }
__device__ __forceinline__ unsigned xb_add(unsigned* p, unsigned v) { return __hip_atomic_fetch_add(p, v, __ATOMIC_RELAXED, __HIP_MEMORY_SCOPE_AGENT); }
__device__ __forceinline__ unsigned xb_xcc_id() { return (unsigned)__builtin_amdgcn_s_getreg((3 << 11) | 20) & 0xFu; }
#define XB_SPIN(cond, bar) do { unsigned _sp = 0; while (cond) { __builtin_amdgcn_s_sleep(1); \
    if ((++_sp & 255u) == 0u) { if (xb_ld(&(bar)[XB_TMO])) break; if (_sp > XB_SPIN_CAP) { atomicAdd(&(bar)[XB_TMO], 1u); break; } } } } while (0)

struct XcdBarrier {
    unsigned* bar; unsigned x;
    volatile LAS unsigned* st;
};

__device__ __forceinline__ XcdBarrier xcd_barrier_post(unsigned* bar, volatile LAS unsigned* st, bool t0) {
    XcdBarrier b; b.bar = bar; b.x = xb_xcc_id(); b.st = st;
    if (t0) (void)xb_add(&bar[XB_XCNT(b.x)], 1u);
    return b;
}
__device__ __forceinline__ void xcd_barrier_complete(unsigned* bar, unsigned x, unsigned& nloc, unsigned& nx) {
    const unsigned G = gridDim.x * gridDim.y * gridDim.z;
    unsigned sum, cnt, mine, sp = 0u;
    for (;;) {
        sum = 0u; cnt = 0u; mine = 0u;
#pragma unroll
        for (unsigned j = 0; j < 16; ++j) { const unsigned c = xb_ld(&bar[XB_XCNT(j)]); sum += c; cnt += (c > 0u) ? 1u : 0u; mine = (j == x) ? c : mine; }
        if (sum == G) break;
        __builtin_amdgcn_s_sleep(1);
        if ((++sp & 255u) == 0u) { if (xb_ld(&bar[XB_TMO])) break; if (sp > XB_SPIN_CAP) { atomicAdd(&bar[XB_TMO], 1u); break; } }
    }
    nloc = mine > 0u ? mine : 1u; nx = cnt > 0u ? cnt : 1u;
}

__device__ __forceinline__ void xcd_barrier(const XcdBarrier& b, bool t0) {
    asm volatile("s_waitcnt vmcnt(0)" ::: "memory");
    __syncthreads();
    if (t0) {
        unsigned* bar = b.bar;
        __builtin_amdgcn_s_waitcnt(0);
        unsigned nloc = b.st[0], nx = b.st[1];
        if (nloc == 0u) { xcd_barrier_complete(bar, b.x, nloc, nx); b.st[0] = nloc; b.st[1] = nx; }
        const unsigned old = xb_add(&bar[XB_XSUB(b.x)], 1u);
        const unsigned gen = old / nloc;
        if (old + 1u == (gen + 1u) * nloc) {
            __builtin_amdgcn_fence(__ATOMIC_RELEASE, "agent");
            asm volatile("s_waitcnt vmcnt(0)" ::: "memory");
            const unsigned og = xb_add(&bar[XB_TOP], 1u);
            const unsigned tg = og / nx;
            if (og + 1u == (tg + 1u) * nx) xb_add(&bar[XB_TOPGEN], 1u);
            else XB_SPIN(xb_ld(&bar[XB_TOPGEN]) == tg, bar);
            __builtin_amdgcn_fence(__ATOMIC_ACQUIRE, "agent");
            xb_add(&bar[XB_XGEN(b.x)], 1u);
            asm volatile("s_waitcnt vmcnt(0)" ::: "memory");
        } else {
            XB_SPIN(xb_ld(&bar[XB_XGEN(b.x)]) == gen, bar);
            __builtin_amdgcn_fence(__ATOMIC_ACQUIRE, "agent");
            asm volatile("s_waitcnt vmcnt(0)" ::: "memory");
        }
    }
    __syncthreads();
}


constexpr int N_PHASES = 22;
#ifndef ONLY_K
#define ONLY_K -1
#endif
#ifndef ONLY_U
#define ONLY_U -1
#endif
#define ENU(uu) (ONLY_U < 0 || ONLY_U == (uu))
#define EN(kk) (ONLY_K < 0 || ONLY_K == (kk))
__global__ void __launch_bounds__(512, 2) fwd_megakernel(Params Pk) {
    Params P = Pk; P.pad = __builtin_amdgcn_readfirstlane((int)threadIdx.x & ~63);
    extern __shared__ __attribute__((aligned(16))) unsigned char lds_raw[];
    LAS unsigned char* lds = (LAS unsigned char*)lds_raw;
    cg::grid_group grid = cg::this_grid();
    volatile LAS unsigned* stw = (volatile LAS unsigned*)(lds + LDS_BYTES - 16);
    { const int t = opaque_tid(P.pad); if (t < 4) stw[t] = 0u; }
    __syncthreads();
    const XcdBarrier bar = xcd_barrier_post((unsigned*)(P.ws + WS_CTL), stw, opaque_tid(P.pad) == 0);
    float* X = P.out;
    for (int ph = P.ph_lo; ph < P.ph_hi; ++ph) {
        if (ph == 0) { if (!(blockIdx.x & 1)) { if (EN(10)) phase_weights(P, lds); __syncthreads(); } }
        else if (ph == 21) phase_final(P);
        else {
            int phv = ph, gdim = gridDim.x, bidx = blockIdx.x; asm volatile("" : "+s"(phv), "+s"(gdim), "+s"(bidx));
            const int l = (phv - 1) / 10, k = (phv - 1) % 10;
            void* XB1 = (void*)(P.ws + WS_XB); void* XB2 = (void*)P.out; const float* XS = (const float*)(P.ws + WS_XS);
            const void* xin = (l == 0) ? (const void*)P.in[I_XP] : (const void*)XB2;
            if (k == 0) { if (EN(0)) phase_norm<true>(P, lds, l, xin, l != 0, l == 0 ? P.in[I_XS] : XS, P.in[I_N1] + l * DM, l == 0 ? 0 : 11);
                if (l == 0 && (bidx & 1)) { __syncthreads(); if (EN(10)) phase_weights(P, lds); } }
            else if (k == 1 && EN(1)) {
                pg8::Gemm g{(const bf16_t*)(P.ws + WS_HN), (const bf16_t*)(P.ws + WS_WIN + l * WIN_L), MT, NPROJ, DM, P.pad, P.rep == 2}; pg8::StaticOrder S; S.init(MT, NPROJ, DM, gdim, bidx);
                pg8::EpiProj E{(bf16_t*)(P.ws + WS_PROJ), NPROJ, P.rep == 3};
                pg8::gemm_phase<pg8::EpiProj, pg8::StaticOrder, false>(lds, g, S, E, nullptr);
            } else if (k == 2 && EN(2)) {
#ifndef PROBE_SUB
#define PROBE_SUB -1
#endif
#define SUBEN(x) (!P.rep || PROBE_SUB < 0 || PROBE_SUB == (x))
#pragma unroll 1
                for (int slot = 0; slot < 4; ++slot) {
                    const int kind = (slot + (bidx >> 3)) & 3;
                    if (kind == 0) {
#pragma unroll 1
                        for (int u = blockIdx.x; u < 512; u += gridDim.x) { if (ENU(0) && SUBEN(0)) ssd_prep_unit(P, lds, l, u >> 1, u & 1); }
                    } else if (kind == 1) {
#pragma unroll 1
                        for (int v = blockIdx.x; v < 512; v += gridDim.x) { if (ENU(1) && SUBEN(1)) attn_prompt_unit(P, lds, l, v >> 7, (v >> 1) & 63, v & 1); }
                    } else if (kind == 2) {
#pragma unroll 1
                        for (int v = blockIdx.x; v < 256; v += gridDim.x) { if (ENU(2) && SUBEN(2)) ssd_sample_unit(P, lds, l, v >> 1, v & 1); }
                    } else {
#pragma unroll 1
                        for (int v = blockIdx.x; v < 256; v += gridDim.x) { if (ENU(3) && SUBEN(3)) attn_sample_unit(P, lds, l, v >> 1, v & 1); }
                    }
                }
            } else if (k == 3 && EN(3)) phase_scan(P, l);
            else if (k == 4 && EN(4)) {
#pragma unroll 1
                for (int u = blockIdx.x; u < 512; u += gridDim.x) ssd_out_unit(P, lds, l, u >> 1, u & 1); }
            else if (k == 5 && EN(5)) {
                pg8::Gemm g{(const bf16_t*)(P.ws + WS_YCAT), (const bf16_t*)(P.ws + WS_WOUT + l * WOUT_L), MT, DM, DM, P.pad, P.rep == 2}; pg8::SplitOrder S; S.init(DM, DM, 4, gdim, bidx);
                pg8::EpiResid E{xin, XB1, (float*)(P.ws + WS_XSL), l != 0, 1};
                pg8::gemm_phase<pg8::EpiResid, pg8::SplitOrder, false>(lds, g, S, E, nullptr);
            } else if (k == 6 && EN(6)) phase_norm<false>(P, lds, l, XB1, 1, XS, P.in[I_N2] + l * DM, 4);
            else if (k == 7 && EN(7)) {
                pg8::Gemm g{(const bf16_t*)(P.ws + WS_HN), (const bf16_t*)(P.ws + WS_WUP + l * WUP_L), MT, NUP, DM, P.pad, P.rep == 2}; pg8::SplitOrder S; S.init(NUP, DM, 4, gdim, bidx);
                pg8::EpiUp E{(bf16_t*)(P.ws + WS_G), (bf16_t*)(P.ws + WS_UH), P.in[I_FCW] + (size_t)l * 3 * NUP, P.in[I_FCB] + (size_t)l * NUP, (float*)(P.ws + WS_US), P.rep >= 3 ? P.rep - 2 : 0};
                pg8::gemm_phase<pg8::EpiUp, pg8::SplitOrder, false>(lds, g, S, E, nullptr);
            } else if (k == 8 && EN(8)) phase_fixup(P, l);
            else if (k == 9 && EN(9)) {
                pg8::Gemm g{(const bf16_t*)(P.ws + WS_G), (const bf16_t*)(P.ws + WS_WDN + l * WDN_L), MT, DM, DFF, P.pad, P.rep == 2}; pg8::SplitOrder S; S.init(DM, DFF, 11, gdim, bidx);
                pg8::EpiResid E{XB1, l == 0 ? XB2 : (void*)X, (float*)(P.ws + WS_XSL), 1, l == 0};
                pg8::gemm_phase<pg8::EpiResid, pg8::SplitOrder, false>(lds, g, S, E, nullptr);
            }
        }
        if (ph + 1 < P.ph_hi && ph != 0) { if (P.ph_hi > 1000) grid.sync(); xcd_barrier(bar, opaque_tid(P.pad) == 0); }
    }
}

extern "C" void kernel_launch(void* const* d_in, const int* in_sizes, int n_in, void* d_out, int out_size, void* d_ws, size_t ws_size, hipStream_t stream) {
    static int grid = 0;
    if (grid == 0) {
        if (n_in != 24 || ws_size < WS_END) { fprintf(stderr, "kernel_launch: unexpected inputs (n_in %d, ws %zu)\n", n_in, ws_size); grid = -1; return; }
        int dev = 0, cus = 0, per_cu = 0;
        hipGetDevice(&dev); hipDeviceGetAttribute(&cus, hipDeviceAttributeMultiprocessorCount, dev);
        hipFuncSetAttribute((const void*)fwd_megakernel, hipFuncAttributeMaxDynamicSharedMemorySize, LDS_BYTES);
        hipOccupancyMaxActiveBlocksPerMultiprocessor(&per_cu, (const void*)fwd_megakernel, 512, LDS_BYTES);
        (void)hipGetLastError();
        if (per_cu < 1) fprintf(stderr, "kernel_launch: occupancy query says %d blocks/CU\n", per_cu);
        grid = cus > 0 ? cus : 256;
    }
    if (grid < 0) return;
    Params p{};
    for (int i = 0; i < 24; ++i) p.in[i] = (const float*)d_in[i];
    p.out = (float*)d_out; p.ws = (unsigned char*)d_ws;
#if MK_MULTI
    for (int ph = 0; ph < N_PHASES; ++ph) { p.ph_lo = ph; p.ph_hi = ph + 1; p.rep = 0; hipLaunchKernelGGL(fwd_megakernel, dim3(grid), dim3(512), LDS_BYTES, stream, p);
#ifdef PROBE_MASK
#ifndef PROBE_REP
#define PROBE_REP 1
#endif
        if (ph <= 10 && ph != 7 && ((PROBE_MASK >> ph) & 1)) { p.rep = PROBE_REP; for (int r = 0; r < 2; ++r) hipLaunchKernelGGL(fwd_megakernel, dim3(grid), dim3(512), LDS_BYTES, stream, p); }
#endif
    }
#else
    p.ph_lo = 0; p.ph_hi = N_PHASES;
    (void)hipMemsetAsync((char*)d_ws + WS_CTL, 0, 65536, stream);
    void* args[] = {&p};
    hipError_t e = hipLaunchCooperativeKernel((const void*)fwd_megakernel, dim3(grid), dim3(512), args, LDS_BYTES, stream);
    if (e != hipSuccess) fprintf(stderr, "cooperative launch failed: %s (grid %d)\n", hipGetErrorString(e), grid);
#endif
}
```

```cpp
#include <hip/hip_runtime.h>
#include <hip/hip_cooperative_groups.h>
#include <cstdio>
#include <cstdint>
namespace cg = cooperative_groups;

#define LAS __attribute__((address_space(3)))
typedef unsigned short bf16_t;
typedef short bf16x8 __attribute__((ext_vector_type(8)));
typedef short bf16x4 __attribute__((ext_vector_type(4)));
typedef float f32x4 __attribute__((ext_vector_type(4)));
typedef float f32x2 __attribute__((ext_vector_type(2)));
typedef unsigned u32x4 __attribute__((ext_vector_type(4)));
typedef unsigned u32x2 __attribute__((ext_vector_type(2)));

#ifndef MK_MULTI
#define MK_MULTI 0
#endif

constexpr int MP = 32768, MS = 512, MT = MP + MS;
constexpr int DM = 1024, NPROJ = 2304, DFF = 2816, NUP = 5632, IN_DIM = 2312;
constexpr int PC_Z = 0, PC_XBC = 512, PC_Q = 1536, PC_K = 2048, PC_V = 2176;
constexpr float EPS = 1e-6f;
constexpr size_t O_Y = 0, O_PSSM = 34078720, O_PCONV = 34603008, O_PK = 34627584, O_PV = 34758656, O_PFFN = 34889728,
                 O_SSSM = 34979840, O_SCONV = 51757056, O_SK = 52543488, O_SV = 56737792, O_SFFN = 60932096;
constexpr size_t MiB = 1u << 20;
constexpr size_t WS_CTL = 0, WS_WIN = 1 * MiB, WS_WOUT = 10 * MiB, WS_WUP = 14 * MiB, WS_WDN = 36 * MiB, WS_HN = 47 * MiB,
                 WS_DT = 112 * MiB, WS_AC = 112 * MiB + 1310720, WS_CD = 112 * MiB + 2621440, WS_XS = 115 * MiB  , WS_XB = 394 * MiB  , WS_YCAT = 117 * MiB, WS_PROJ = 182 * MiB,
                 WS_XTG = 329 * MiB, WS_BCN = 361 * MiB, WS_ST = 394 * MiB, WS_G = 182 * MiB, WS_UH = 361 * MiB, WS_PSTB = 458 * MiB, WS_US = 117 * MiB  , WS_XSL = 458 * MiB  , WS_END = 490 * MiB;
constexpr size_t WIN_L = (size_t)NPROJ * DM * 2, WOUT_L = (size_t)DM * DM * 2, WUP_L = (size_t)NUP * DM * 2, WDN_L = (size_t)DM * DFF * 2;
constexpr int LDS_BYTES = 155648;

__device__ __forceinline__ float bf2f(unsigned b) { return __uint_as_float(b << 16); }
__device__ __forceinline__ unsigned pk2(float lo, float hi) { unsigned r; asm volatile("v_cvt_pk_bf16_f32 %0, %1, %2" : "=v"(r) : "v"(lo), "v"(hi)); return r; }
__device__ __forceinline__ float silu_f(float x) { return x * __builtin_amdgcn_rcpf(1.f + __expf(-x)); }

template <int CTRL> __device__ __forceinline__ float dpp0(float x) {
    return __builtin_bit_cast(float, __builtin_amdgcn_update_dpp(0, __builtin_bit_cast(int, x), CTRL, 0xf, 0xf, true));
}
#define DPP_SHR1 0x111
#define DPP_SHR2 0x112
#define DPP_SHL14 0x10E
#define DPP_SHL15 0x10F
__device__ __forceinline__ bf16x8 cvt8(const f32x4 a, const f32x4 b) {
    u32x4 w; w.x = pk2(a[0], a[1]); w.y = pk2(a[2], a[3]); w.z = pk2(b[0], b[1]); w.w = pk2(b[2], b[3]);
    return __builtin_bit_cast(bf16x8, w);
}
__device__ __forceinline__ int lane_now() { int l; asm volatile("v_mbcnt_lo_u32_b32 %0, -1, 0\n\tv_mbcnt_hi_u32_b32 %0, -1, %0" : "=v"(l)); return l; }
__device__ __forceinline__ int opaque_tid(int wbase) { return wbase + lane_now(); }
__device__ __forceinline__ float shx(float v, int o, int lane) { return __builtin_bit_cast(float, __builtin_amdgcn_ds_bpermute((lane ^ o) << 2, __builtin_bit_cast(int, v))); }
__device__ __forceinline__ float shi(float v, int idx) { return __builtin_bit_cast(float, __builtin_amdgcn_ds_bpermute(idx << 2, __builtin_bit_cast(int, v))); }
__device__ __forceinline__ void gatomic_add(float* p, float v) { (void)__builtin_amdgcn_global_atomic_fadd_f32((__attribute__((address_space(1))) float*)p, v); }
__device__ __forceinline__ float wave_sum(float v, int lane) {
#pragma unroll
    for (int o = 1; o < 64; o <<= 1) v += shx(v, o, lane);
    return v;
}
__device__ __forceinline__ float wave_sum2(float v, int lane) {
    v += dpp0<0xB1>(v); v += dpp0<0x4E>(v); v += dpp0<0x141>(v); v += dpp0<0x140>(v);
    v += shx(v, 16, lane); v += shx(v, 32, lane);
    return v;
}
namespace pg8 {
#define PG8_LAS __attribute__((address_space(3)))
typedef unsigned short bf16_t;
typedef short bf16x8 __attribute__((ext_vector_type(8)));
typedef float f32x4 __attribute__((ext_vector_type(4)));
typedef unsigned u32x4 __attribute__((ext_vector_type(4)));
constexpr int BM = 256, BK = 64, HALF = 128, HTB = HALF * BK * 2  , STAGE_BYTES = 8 * HTB, NXCD = 8, WGM = 8;

__host__ __device__ __forceinline__ int lds_byte(int r, int c) { const int st = (r >> 4) * 2 + (c >> 5), rr = r & 15, cc = c & 31, ob = rr * 64 + cc * 2; return st * 1024 + (ob ^ (((ob >> 9) & 1) << 5)); }
__host__ __device__ __forceinline__ void stage_rc(int b, int& R, int& C) { const int st = b / 1024, sb = b % 1024, swz = sb ^ (((sb >> 9) & 1) << 5); R = (st >> 1) * 16 + swz / 64; C = (st & 1) * 32 + (swz % 64) / 2; }
__host__ __device__ __forceinline__ int perm32(int rho) { const int n = rho >> 4, i = rho & 15; return 8 * (i >> 2) + 4 * n + (i & 3); }

struct Unit { int pm, pn, k0, nt; };
struct Gemm { const bf16_t* A; const bf16_t* Bt; int M, N, K, wbase, skip; };

struct StaticOrder {
    int nM, nN, nwg, G, c, ntk;
    __host__ __device__ void init(int M, int N, int K, int G_, int c_) { nM = M / BM; nN = N / BM; nwg = nM * nN; G = G_; c = c_; ntk = K / BK; }
    __host__ __device__ bool next(int i, Unit& u) const {
        const long L = (long)i * G + c; if (L >= nwg) return false;
        int wgid = (int)L; { const int q = nwg / NXCD, r = nwg % NXCD, xcd = wgid % NXCD, off = wgid / NXCD; wgid = (xcd < r ? xcd * (q + 1) : r * (q + 1) + (xcd - r) * q) + off; }
        const int nig = WGM * nN, gid = wgid / nig, fm = gid * WGM, gsz = (nM - fm) < WGM ? (nM - fm) : WGM;
        u.pm = fm + ((wgid % nig) % gsz); u.pn = (wgid % nig) / gsz; u.k0 = 0; u.nt = ntk; return true;
    }
    __device__ __forceinline__ void a_ready(const Unit&) const {}
    __device__ __forceinline__ void done(const Unit&) const {}
};

struct SplitOrder {
    int nN, nP, nwg, G, c, nsplit, ntk;
    __host__ __device__ void init(int N, int K, int nsplit_, int G_, int c_) { nN = N / BM; nP = 128 * nN; nsplit = nsplit_; nwg = nP + 2 * nN * nsplit; G = G_; c = c_; ntk = K / BK; }
    __host__ __device__ bool next(int i, Unit& u) const {
        const int L = i * G + c; if (L >= nwg) return false;
        const bool pr = L < nP;
        const int wl = pr ? L : 0, wgid = (wl % NXCD) * (nP / NXCD) + wl / NXCD;
        const int nig = WGM * nN, gid = wgid / nig, rem = wgid % nig;
        const int s = pr ? 0 : L - nP, s2 = s >> 1, ks = s2 / nN, nts = ntk / nsplit;
        const int pm = pr ? gid * WGM + rem % WGM : 128 + (s & 1);
        const int pn = pr ? rem / WGM : s2 % nN;
        const int k0 = pr ? 0 : ks * nts * BK;
        const int nt = pr ? ntk : nts;
        u.pm = pm; u.pn = pn; u.k0 = k0; u.nt = nt;
        return true;
    }
    __device__ __forceinline__ void a_ready(const Unit&) const {}
    __device__ __forceinline__ void done(const Unit&) const {}
};
struct EpiProj {
    static constexpr bool PERM = true, AFTER_DRAIN = false;
    bf16_t* O; int ldc; int half;
    __device__ __forceinline__ void operator()(const f32x4 (&acc)[2][2][4][2], const Unit& u, int wr, int wc, int fr, int fq) const {
        { const int ln = lane_now(); fr = ln & 15; fq = ln >> 4; }
        const int row0 = u.pm * BM + wr * 64 + fr, col0 = u.pn * BM + wc * 32 + 8 * fq;
#pragma unroll
        for (int ai = 0; ai < 2; ++ai)
#pragma unroll
            for (int m = 0; m < 4; ++m) { if (half && ai == 1) continue; bf16_t* rowp = O + (size_t)(row0 + ai * HALF + m * 16) * ldc + col0;
#pragma unroll
                for (int bj = 0; bj < 2; ++bj) { const f32x4 v0 = acc[ai][bj][m][0], v1 = acc[ai][bj][m][1];
                    u32x4 w; w.x = pk2(v0[0], v0[1]); w.y = pk2(v0[2], v0[3]); w.z = pk2(v1[0], v1[1]); w.w = pk2(v1[2], v1[3]);
                    *(u32x4*)(rowp + bj * HALF) = w; } }
    }
};
struct EpiResid {
    static constexpr bool PERM = true, AFTER_DRAIN = false;
    const void* res; void* out; float* slab; int res_bf16, out_bf16;
    __device__ __forceinline__ void operator()(const f32x4 (&acc)[2][2][4][2], const Unit& u, int wr, int wc, int fr, int fq) const {
        { const int ln = lane_now(); fr = ln & 15; fq = ln >> 4; }
        const int row0 = u.pm * BM + wr * 64 + fr, col0 = u.pn * BM + wc * 32 + 8 * fq;
#pragma unroll
        for (int ai = 0; ai < 2; ++ai)
#pragma unroll
            for (int m = 0; m < 4; ++m) { const int row = row0 + ai * HALF + m * 16;
                if (u.pm >= 128) {
                    float* sp = slab + ((size_t)(u.k0 / (u.nt * BK)) * MS + (row - MP)) * DM + col0;
#pragma unroll
                    for (int bj = 0; bj < 2; ++bj)
#pragma unroll
                        for (int n = 0; n < 2; ++n) *(f32x4*)(sp + bj * HALF + 4 * n) = acc[ai][bj][m][n];
                } else {
                    f32x4 rv[2][2];
                    if (res_bf16) { const bf16_t* rp = (const bf16_t*)res + (size_t)row * DM + col0;
#pragma unroll
                        for (int bj = 0; bj < 2; ++bj) { const u32x4 t = *(const u32x4*)(rp + bj * HALF);
                            rv[bj][0] = (f32x4){bf2f(t.x & 0xffffu), bf2f(t.x >> 16), bf2f(t.y & 0xffffu), bf2f(t.y >> 16)}; rv[bj][1] = (f32x4){bf2f(t.z & 0xffffu), bf2f(t.z >> 16), bf2f(t.w & 0xffffu), bf2f(t.w >> 16)}; }
                    } else { const float* rp = (const float*)res + (size_t)row * DM + col0;
#pragma unroll
                        for (int bj = 0; bj < 2; ++bj)
#pragma unroll
                            for (int n = 0; n < 2; ++n) rv[bj][n] = *(const f32x4*)(rp + bj * HALF + 4 * n);
                    }
                    if (out_bf16) { bf16_t* op = (bf16_t*)out + (size_t)row * DM + col0;
#pragma unroll
                        for (int bj = 0; bj < 2; ++bj) { const f32x4 v0 = rv[bj][0] + acc[ai][bj][m][0], v1 = rv[bj][1] + acc[ai][bj][m][1];
                            u32x4 w; w.x = pk2(v0[0], v0[1]); w.y = pk2(v0[2], v0[3]); w.z = pk2(v1[0], v1[1]); w.w = pk2(v1[2], v1[3]); *(u32x4*)(op + bj * HALF) = w; }
                    } else { float* op = (float*)out + (size_t)row * DM + col0;
#pragma unroll
                        for (int bj = 0; bj < 2; ++bj)
#pragma unroll
                            for (int n = 0; n < 2; ++n) *(f32x4*)(op + bj * HALF + 4 * n) = rv[bj][n] + acc[ai][bj][m][n];
                    }
                } }
    }
};
struct EpiUp {
    static constexpr bool PERM = true, AFTER_DRAIN = false;
    bf16_t* G; bf16_t* UH; const float* cw; const float* cb; float* US; int nost;
    __device__ __forceinline__ void operator()(const f32x4 (&acc)[2][2][4][2], const Unit& u, int wr, int wc, int fr, int fq) const {
        { const int ln = lane_now(); fr = ln & 15; fq = ln >> 4; }
        const int jbase = u.pn * 128 + wc * 32 + 8 * fq;
        if (u.pm >= 128) {
            float* sb = US + (size_t)(u.k0 / (u.nt * BK)) * MS * NUP;
#pragma unroll
            for (int ai = 0; ai < 2; ++ai)
#pragma unroll
                for (int m = 0; m < 4; ++m) { __builtin_amdgcn_sched_barrier(0); float* up = sb + (size_t)(u.pm * BM + ai * HALF + wr * 64 + 16 * m + fr - MP) * NUP + jbase;
#pragma unroll
                    for (int n = 0; n < 2; ++n) { *(f32x4*)(up + 4 * n) = acc[ai][0][m][n]; *(f32x4*)(up + DFF + 4 * n) = acc[ai][1][m][n]; } }
            return;
        }
        f32x4 prm[2][8];
#pragma unroll
        for (int n = 0; n < 2; ++n) { const int j = jbase + 4 * n;
            prm[n][0] = *(const f32x4*)(cw + j); prm[n][1] = *(const f32x4*)(cw + NUP + j); prm[n][2] = *(const f32x4*)(cw + 2 * NUP + j); prm[n][3] = *(const f32x4*)(cb + j);
            prm[n][4] = *(const f32x4*)(cw + DFF + j); prm[n][5] = *(const f32x4*)(cw + NUP + DFF + j); prm[n][6] = *(const f32x4*)(cw + 2 * NUP + DFF + j); prm[n][7] = *(const f32x4*)(cb + DFF + j); }
#pragma unroll
        for (int ai = 0; ai < 2; ++ai) {
            const int rowg = u.pm * BM + ai * HALF + wr * 64;
#pragma unroll
            for (int m = 0; m < 4; ++m) {
                __builtin_amdgcn_sched_barrier(0);
                const int r = rowg + 16 * m + fr;
                unsigned pk[4];
#pragma unroll
                for (int n = 0; n < 2; ++n) {
                    const f32x4 w0g = prm[n][0], w1g = prm[n][1], w2g = prm[n][2], bg = prm[n][3], w0v = prm[n][4], w1v = prm[n][5], w2v = prm[n][6], bv = prm[n][7];
                    const f32x4 vg = acc[ai][0][m][n], vv = acc[ai][1][m][n];
                    const f32x4 tg = w1g * vg, sg = w0g * vg, tv = w1v * vv, sv = w0v * vv;
                    f32x4 cg_ = w2g * vg + bg, cv_ = w2v * vv + bv;
#pragma unroll
                    for (int i = 0; i < 4; ++i) {
                        cg_[i] += dpp0<DPP_SHR1>(tg[i] + dpp0<DPP_SHR1>(sg[i]));
                        cv_[i] += dpp0<DPP_SHR1>(tv[i] + dpp0<DPP_SHR1>(sv[i]));
                        if (m > 0) { const float og = acc[ai][0][m > 0 ? m - 1 : 0][n][i], ov = acc[ai][1][m > 0 ? m - 1 : 0][n][i];
                            cg_[i] += dpp0<DPP_SHL15>(w1g[i] * og) + dpp0<DPP_SHL14>(w0g[i] * og); cv_[i] += dpp0<DPP_SHL15>(w1v[i] * ov) + dpp0<DPP_SHL14>(w0v[i] * ov); }
                    }
                    pk[2 * n] = pk2(silu_f(cg_[0]) * cv_[0], silu_f(cg_[1]) * cv_[1]); pk[2 * n + 1] = pk2(silu_f(cg_[2]) * cv_[2], silu_f(cg_[3]) * cv_[3]);
                }
                int slot = -1;
                if (m == 0 && fr < 2) slot = fr; else if (m == 3 && fr >= 14) slot = fr - 12;
                if (slot >= 0 && !(nost & 2)) { bf16_t* up = UH + ((size_t)(r >> 6) * 4 + slot) * NUP + jbase;
                    const f32x4 g0 = acc[ai][0][m][0], g1 = acc[ai][0][m][1], v0 = acc[ai][1][m][0], v1 = acc[ai][1][m][1];
                    u32x4 a, b2; a.x = pk2(g0[0], g0[1]); a.y = pk2(g0[2], g0[3]); a.z = pk2(g1[0], g1[1]); a.w = pk2(g1[2], g1[3]);
                    b2.x = pk2(v0[0], v0[1]); b2.y = pk2(v0[2], v0[3]); b2.z = pk2(v1[0], v1[1]); b2.w = pk2(v1[2], v1[3]);
                    *(u32x4*)up = a; *(u32x4*)(up + DFF) = b2; }
                if (!(m == 0 && fr < 2) && !(nost & 1)) { u32x4 w; w.x = pk[0]; w.y = pk[1]; w.z = pk[2]; w.w = pk[3]; *(u32x4*)(G + (size_t)r * DFF + jbase) = w; }
            }
        }
    }
};
template <class Epi, class Sched, bool STAMP = false>
__device__ __forceinline__ void gemm_phase(PG8_LAS unsigned char* lds, const Gemm g, const Sched& S, const Epi& E, unsigned long long* stamps) {
    const int tid = opaque_tid(g.wbase), wid = __builtin_amdgcn_readfirstlane(tid >> 6), lane = tid & 63, wr = wid >> 2, wc = wid & 3, fr = lane & 15, fq = lane >> 4;
    const int K = g.K;
    int ts_lo = 0, ts_hi = 0, nts = 0; const unsigned long long rt_entry = STAMP ? (unsigned long long)wall_clock64() : 0ull;
#define PG8_STAMP() do { if (STAMP && wid == 0 && nts < 64) { const unsigned long long _c = (unsigned long long)clock64(); \
        ts_lo = (lane == nts) ? (int)(unsigned)_c : ts_lo; ts_hi = (lane == nts) ? (int)(unsigned)(_c >> 32) : ts_hi; ++nts; } } while (0)
    PG8_STAMP();
    unsigned voffA[2], voffB[2];
#pragma unroll
    for (int i = 0; i < 2; ++i) { int R, C; stage_rc(tid * 16 + i * 8192, R, C); const int Rb = Epi::PERM ? ((R & ~31) + perm32(R & 31)) : R;
        voffA[i] = (unsigned)(R * K + C) * 2u; voffB[i] = (unsigned)(Rb * K + C) * 2u; }
    const size_t kstep = (size_t)(BK * 2);
    const size_t hstep = (size_t)HALF * K * 2;
    const size_t tstep = 2 * hstep;
    const unsigned ldsw = (unsigned)wid * 1024u;
    const int aoff = lds_byte(wr * 64 + fr, fq * 8), boff = lds_byte(wc * 32 + fr, fq * 8);
#define PG8_SA(b, h) (((b) * 2 + (h)) * HTB)
#define PG8_SB(b, h) ((4 + (b) * 2 + (h)) * HTB)
#define PG8_STAGE(bufoff, gbase, voff) do { _Pragma("unroll") for (int _i = 0; _i < 2; ++_i) \
        __builtin_amdgcn_global_load_lds((const unsigned*)((const char*)(gbase) + (voff)[_i]), (PG8_LAS unsigned*)(lds + (bufoff) + ldsw + _i * 8192), 16, 0, 0); } while (0)
#define PG8_LDA(dst, b, h) do { _Pragma("unroll") for (int m = 0; m < 4; ++m) _Pragma("unroll") for (int k = 0; k < 2; ++k) dst[m][k] = *(const PG8_LAS bf16x8*)(lds + PG8_SA(b, h) + aoff + m * 2048 + k * 1024); } while (0)
#define PG8_LDB(dst, b, h) do { _Pragma("unroll") for (int n = 0; n < 2; ++n) _Pragma("unroll") for (int k = 0; k < 2; ++k) dst[n][k] = *(const PG8_LAS bf16x8*)(lds + PG8_SB(b, h) + boff + n * 2048 + k * 1024); } while (0)
#define PG8_MMA(ai, bj, At, Bt) do { __builtin_amdgcn_s_setprio(1); _Pragma("unroll") for (int m = 0; m < 4; ++m) _Pragma("unroll") for (int n = 0; n < 2; ++n) _Pragma("unroll") for (int k = 0; k < 2; ++k) \
        acc[ai][bj][m][n] = __builtin_amdgcn_mfma_f32_16x16x32_bf16(Bt[n][k], At[m][k], acc[ai][bj][m][n], 0, 0, 0); __builtin_amdgcn_s_setprio(0); } while (0)
#define PG8_WAIT_V(n) asm volatile("s_waitcnt vmcnt(" #n ")" ::: "memory")
#define PG8_WAIT_L(n) asm volatile("s_waitcnt lgkmcnt(" #n ")" ::: "memory")
#define PG8_BAR __builtin_amdgcn_s_barrier()
#define PG8_SCHED __builtin_amdgcn_sched_barrier(0)
    Unit cur, nxt; int ui = 0;
    if (!S.next(0, cur)) return;
    f32x4 acc[2][2][4][2];
#pragma unroll
    for (int a = 0; a < 2; ++a)
#pragma unroll
        for (int b = 0; b < 2; ++b)
#pragma unroll
            for (int m = 0; m < 4; ++m)
#pragma unroll
                for (int n = 0; n < 2; ++n) acc[a][b][m][n] = (f32x4){0.f, 0.f, 0.f, 0.f};
    bf16x8 At[4][2], B0[2][2], B1[2][2];
    const char* cA = (const char*)g.A + (size_t)cur.pm * tstep + (size_t)cur.k0 * 2; const char* cB = (const char*)g.Bt + (size_t)cur.pn * tstep + (size_t)cur.k0 * 2;
    S.a_ready(cur);
    PG8_STAGE(PG8_SB(0, 0), cB, voffB); PG8_STAGE(PG8_SB(0, 1), cB + hstep, voffB); PG8_STAGE(PG8_SA(0, 0), cA, voffA); PG8_STAGE(PG8_SA(0, 1), cA + hstep, voffA);
    if (wr == 1) PG8_BAR;
    PG8_WAIT_V(2); PG8_BAR;
    PG8_STAGE(PG8_SB(1, 0), cB + kstep, voffB); PG8_STAGE(PG8_SA(1, 0), cA + kstep, voffA); PG8_STAGE(PG8_SB(1, 1), cB + hstep + kstep, voffB);
    PG8_WAIT_V(6); PG8_BAR;
    PG8_STAMP();
    for (;;) {
        const bool has_next = S.next(ui + 1, nxt);
        const char* nA = has_next ? (const char*)g.A + (size_t)nxt.pm * tstep + (size_t)nxt.k0 * 2 : cA; const char* nB = has_next ? (const char*)g.Bt + (size_t)nxt.pn * tstep + (size_t)nxt.k0 * 2 : cB;
        const int nt = cur.nt;
        for (int t = 0; t < nt; t += 2) {
            const bool last = (t == nt - 2);
            const char* a1 = cA + (size_t)(t + 1) * kstep;
            const char* a2 = last ? nA : cA + (size_t)(t + 2) * kstep; const char* b2 = last ? nB : cB + (size_t)(t + 2) * kstep;
            const char* a3 = a2 + kstep; const char* b3 = b2 + kstep;
            if (last && has_next) S.a_ready(nxt);
            PG8_LDB(B0, 0, 0); PG8_LDB(B1, 0, 1); PG8_SCHED; PG8_LDA(At, 0, 0); PG8_STAGE(PG8_SA(1, 1), a1 + hstep, voffA);
            PG8_WAIT_V(8); PG8_WAIT_L(0); PG8_BAR; PG8_MMA(0, 0, At, B0); PG8_MMA(0, 1, At, B1); PG8_BAR; PG8_SCHED;
            PG8_LDA(At, 0, 1); PG8_STAGE(PG8_SB(0, 0), b2, voffB); PG8_STAGE(PG8_SB(0, 1), b2 + hstep, voffB); PG8_STAGE(PG8_SA(0, 0), a2, voffA);
            PG8_WAIT_V(8); PG8_WAIT_L(0); PG8_BAR; PG8_MMA(1, 0, At, B0); PG8_MMA(1, 1, At, B1); PG8_BAR; PG8_SCHED;
            PG8_LDB(B0, 1, 0); PG8_LDB(B1, 1, 1); PG8_SCHED; PG8_LDA(At, 1, 0); PG8_STAGE(PG8_SA(0, 1), a2 + hstep, voffA);
            PG8_WAIT_V(8); PG8_WAIT_L(0); PG8_BAR; PG8_MMA(0, 0, At, B0); PG8_MMA(0, 1, At, B1); PG8_BAR; PG8_SCHED;
            PG8_LDA(At, 1, 1); PG8_STAGE(PG8_SB(1, 0), b3, voffB); PG8_STAGE(PG8_SB(1, 1), b3 + hstep, voffB); PG8_STAGE(PG8_SA(1, 0), a3, voffA);
            PG8_WAIT_V(8); PG8_WAIT_L(0); PG8_BAR; PG8_MMA(1, 0, At, B0); PG8_MMA(1, 1, At, B1); PG8_BAR; PG8_SCHED;
        }
        PG8_STAMP();
        if (wr == 0) PG8_BAR;
        if constexpr (!Epi::AFTER_DRAIN) { if (!g.skip) E(acc, cur, wr, wc, fr, fq); S.done(cur); }
        PG8_STAMP();
        if (!has_next) break;
#pragma unroll
        for (int a = 0; a < 2; ++a)
#pragma unroll
            for (int b = 0; b < 2; ++b)
#pragma unroll
                for (int m = 0; m < 4; ++m)
#pragma unroll
                    for (int n = 0; n < 2; ++n) acc[a][b][m][n] = (f32x4){0.f, 0.f, 0.f, 0.f};
        cur = nxt; cA = nA; cB = nB; ++ui;
        if (wr == 1) PG8_BAR;
    }
    PG8_WAIT_V(0);
    PG8_BAR;
    if constexpr (Epi::AFTER_DRAIN) { E.fused(acc, cur, wr, wc, fr, fq, lds, wid, lane); S.done(cur); }
    PG8_STAMP();
    if (STAMP && wid == 0) { stamps[lane] = lane < nts ? (((unsigned long long)(unsigned)ts_hi << 32) | (unsigned)ts_lo) : 0ull;
        if (lane == 62) stamps[62] = rt_entry; if (lane == 63) stamps[63] = (unsigned long long)wall_clock64(); }
#undef PG8_STAMP
#undef PG8_SA
#undef PG8_SB
#undef PG8_STAGE
#undef PG8_LDA
#undef PG8_LDB
#undef PG8_MMA
#undef PG8_WAIT_V
#undef PG8_WAIT_L
#undef PG8_BAR
#undef PG8_SCHED
}
}

struct Params { const float* in[24]; float* out; unsigned char* ws; int ph_lo, ph_hi, rep, pad; };
enum { I_XP = 0, I_XS, I_SSM, I_SCONV, I_CK, I_CV, I_SFFN, I_N1, I_WIN, I_CW, I_CB, I_DTB, I_ALOG, I_DSKIP, I_SNORM, I_QN, I_KN, I_SINK, I_WOUT, I_N2, I_WUP, I_FCW, I_FCB, I_WDN };

__device__ __forceinline__ void transpose_item(const float* W, int K, int N, int srccol0, bf16_t* WT, int dstrow0, int k0, LAS float* scr, int lane) {
    float tmp[32];
#pragma unroll
    for (int i = 0; i < 32; ++i) tmp[i] = W[(size_t)(k0 + 2 * i + (lane >> 5)) * N + srccol0 + (lane & 31)];
#pragma unroll
    for (int i = 0; i < 32; ++i) scr[(2 * i + (lane >> 5)) * 33 + (lane & 31)] = tmp[i];
    asm volatile("s_waitcnt lgkmcnt(0)" ::: "memory");
    const int c = lane & 7;
#pragma unroll
    for (int j = 0; j < 4; ++j) { const int n = (lane >> 3) + 8 * j; const LAS float* s = scr + (8 * c) * 33 + n;
        u32x4 o; o.x = pk2(s[0 * 33], s[1 * 33]); o.y = pk2(s[2 * 33], s[3 * 33]); o.z = pk2(s[4 * 33], s[5 * 33]); o.w = pk2(s[6 * 33], s[7 * 33]);
        *(u32x4*)(WT + (size_t)(dstrow0 + n) * K + k0 + 8 * c) = o; }
    asm volatile("s_waitcnt lgkmcnt(0)" ::: "memory");
}
__device__ __forceinline__ void phase_weights(const Params& P, LAS unsigned char* lds) {
    const int tid = opaque_tid(P.pad), lane = tid & 63, wave = tid >> 6;
    LAS float* scr = (LAS float*)(lds + wave * 16384);
    const int gw = blockIdx.x * 8 + wave, NGW = gridDim.x * 8;
    constexpr int I_A = 16 * 72, I_B = 16 * 32, I_C = 16 * 176, I_D = 44 * 32, PER = I_A + I_B + I_C + I_D;
    for (int it = gw; it < 2 * PER; it += NGW) {
        const int l = it / PER; int r = it % PER;
        if (r < I_A) { const int kb = r / 72, nb = r % 72, n0 = 32 * nb;
            transpose_item(P.in[I_WIN] + (size_t)l * DM * IN_DIM, DM, IN_DIM, n0 + (n0 >= 1536 ? 8 : 0), (bf16_t*)(P.ws + WS_WIN + l * WIN_L), n0, 64 * kb, scr, lane); continue; }
        r -= I_A;
        if (r < I_B) { const int kb = r / 32, nb = r % 32;
            transpose_item(P.in[I_WOUT] + (size_t)l * DM * DM, DM, DM, 32 * nb, (bf16_t*)(P.ws + WS_WOUT + l * WOUT_L), 32 * nb, 64 * kb, scr, lane); continue; }
        r -= I_B;
        if (r < I_C) { const int kb = r / 176, nb = r % 176, n0 = 32 * nb, pn = n0 >> 8, rem = n0 & 255, bj = rem >> 7, cc = rem & 127;
            transpose_item(P.in[I_WUP] + (size_t)l * DM * NUP, DM, NUP, bj * DFF + pn * 128 + cc, (bf16_t*)(P.ws + WS_WUP + l * WUP_L), n0, 64 * kb, scr, lane); continue; }
        r -= I_C;
        { const int kb = r / 32, nb = r % 32;
            transpose_item(P.in[I_WDN] + (size_t)l * DFF * DM, DFF, DM, 32 * nb, (bf16_t*)(P.ws + WS_WDN + l * WDN_L), 32 * nb, 64 * kb, scr, lane); }
    }
}

template <bool WITH_DT>
__device__ __forceinline__ void phase_norm(const Params& P, LAS unsigned char* lds, int l, const void* xP, int xP_bf16, const float* xS, const float* nw, int nslab) {
    const int tid = opaque_tid(P.pad), lane = tid & 63, wave = tid >> 6;
    bf16_t* HN = (bf16_t*)(P.ws + WS_HN);
    LAS float* WD = (LAS float*)lds;
    if (WITH_DT) {
        const float* win = P.in[I_WIN] + (size_t)l * DM * IN_DIM + 1536;
        for (int e = tid; e < DM * 8; e += 512) WD[(e & 7) * DM + (e >> 3)] = win[(size_t)(e >> 3) * IN_DIM + (e & 7)];
        __syncthreads();
    }
    f32x4 wv[4];
#pragma unroll
    for (int j = 0; j < 2; ++j) { wv[2 * j] = *(const f32x4*)(nw + 8 * lane + 512 * j); wv[2 * j + 1] = *(const f32x4*)(nw + 8 * lane + 512 * j + 4); }
    const int gw = blockIdx.x * 8 + wave, NGW = gridDim.x * 8;
    u32x4 nx[4];
#define NORM_LOAD(dst, r) do { if ((r) < MP && xP_bf16) { const bf16_t* xr_ = (const bf16_t*)xP + (size_t)(r) * DM + 8 * lane; dst[0] = *(const u32x4*)xr_; dst[1] = *(const u32x4*)(xr_ + 512); } \
        else if ((r) < MT) { const float* xr_ = ((r) < MP) ? (const float*)xP + (size_t)(r) * DM + 8 * lane : xS + (size_t)((r) - MP) * DM + 8 * lane; \
            dst[0] = *(const u32x4*)xr_; dst[1] = *(const u32x4*)(xr_ + 4); dst[2] = *(const u32x4*)(xr_ + 512); dst[3] = *(const u32x4*)(xr_ + 516); } } while (0)
    NORM_LOAD(nx, gw);
    for (int row = gw; row < MT; row += NGW) {
        f32x4 v[4]; float s = 0.f;
        u32x4 cu[4];
#pragma unroll
        for (int j = 0; j < 4; ++j) cu[j] = nx[j];
        { const int rn = row + NGW; NORM_LOAD(nx, rn); }
        if (row < MP && xP_bf16) {
#pragma unroll
            for (int j = 0; j < 2; ++j) { v[2 * j] = (f32x4){bf2f(cu[j].x & 0xffffu), bf2f(cu[j].x >> 16), bf2f(cu[j].y & 0xffffu), bf2f(cu[j].y >> 16)};
                v[2 * j + 1] = (f32x4){bf2f(cu[j].z & 0xffffu), bf2f(cu[j].z >> 16), bf2f(cu[j].w & 0xffffu), bf2f(cu[j].w >> 16)}; }
        } else {
#pragma unroll
            for (int j = 0; j < 4; ++j) v[j] = __builtin_bit_cast(f32x4, cu[j]);
        }
        if (row >= MP) {
            const float* sl = (const float*)(P.ws + WS_XSL) + (size_t)(row - MP) * DM + 8 * lane;
            for (int k = 0; k < nslab; ++k)
#pragma unroll
                for (int j = 0; j < 2; ++j) { v[2 * j] = v[2 * j] + *(const f32x4*)(sl + (size_t)k * MS * DM + 512 * j); v[2 * j + 1] = v[2 * j + 1] + *(const f32x4*)(sl + (size_t)k * MS * DM + 512 * j + 4); }
            float* xo = (float*)(P.ws + WS_XS) + (size_t)(row - MP) * DM + 8 * lane;
#pragma unroll
            for (int j = 0; j < 2; ++j) { *(f32x4*)(xo + 512 * j) = v[2 * j]; *(f32x4*)(xo + 512 * j + 4) = v[2 * j + 1]; }
        }
#pragma unroll
        for (int j = 0; j < 4; ++j) s += (v[j][0] * v[j][0] + v[j][1] * v[j][1]) + (v[j][2] * v[j][2] + v[j][3] * v[j][3]);
        const float rstd = rsqrtf(wave_sum2(s, lane) * (1.f / DM) + EPS);
#pragma unroll
        for (int j = 0; j < 4; ++j) v[j] = v[j] * rstd * wv[j];
#pragma unroll
        for (int j = 0; j < 2; ++j) { u32x4 o; o.x = pk2(v[2 * j][0], v[2 * j][1]); o.y = pk2(v[2 * j][2], v[2 * j][3]); o.z = pk2(v[2 * j + 1][0], v[2 * j + 1][1]); o.w = pk2(v[2 * j + 1][2], v[2 * j + 1][3]);
            *(u32x4*)(HN + (size_t)row * DM + 8 * lane + 512 * j) = o; }
        if (WITH_DT) {
            float d[8];
#pragma unroll
            for (int h = 0; h < 8; ++h) d[h] = 0.f;
#pragma unroll
            for (int h = 0; h < 8; ++h)
#pragma unroll
                for (int j = 0; j < 2; ++j) { const f32x4 a = *(const LAS f32x4*)(WD + h * DM + 8 * lane + 512 * j), b = *(const LAS f32x4*)(WD + h * DM + 8 * lane + 512 * j + 4);
                    d[h] += ((v[2 * j][0] * a[0] + v[2 * j][1] * a[1]) + (v[2 * j][2] * a[2] + v[2 * j][3] * a[3])) + ((v[2 * j + 1][0] * b[0] + v[2 * j + 1][1] * b[1]) + (v[2 * j + 1][2] * b[2] + v[2 * j + 1][3] * b[3])); }
#pragma unroll
            for (int h = 0; h < 8; ++h) d[h] = wave_sum2(d[h], lane);
            if (lane < 8) { float dv = d[0];
#pragma unroll
                for (int h = 1; h < 8; ++h) dv = (lane == h) ? d[h] : dv;
                dv += P.in[I_DTB][l * 8 + lane];
                const float e = __expf(-fabsf(dv));
                const float sp = fmaxf(dv, 0.f) + (e < 0.03f ? e * (1.f - e * (0.5f - e * (0.33333333f - 0.25f * e))) : __logf(1.f + e));
                ((float*)(P.ws + WS_DT))[(size_t)row * 8 + lane] = sp; }
        }
    }
#undef NORM_LOAD
}

__device__ __forceinline__ void attn_tile(const u32x4 a, const u32x4 b, const float* qw, const LAS bf16_t* Ks, const LAS bf16_t* VT, int jj0, int relbase, int kmin, int kmax,
                                          float slope, float sink, bf16_t* out, int r, int q) {
    const int lane = r + 16 * q;
    bf16x8 qf[2];
    {
        float x[16];
#pragma unroll
        for (int i = 0; i < 4; ++i) { x[2 * i] = bf2f(a[i] & 0xffffu); x[2 * i + 1] = bf2f(a[i] >> 16); x[8 + 2 * i] = bf2f(b[i] & 0xffffu); x[8 + 2 * i + 1] = bf2f(b[i] >> 16); }
        float ss = 0.f;
#pragma unroll
        for (int i = 0; i < 16; ++i) ss += x[i] * x[i];
        ss += shx(ss, 16, lane); ss += shx(ss, 32, lane);
        const float sc = rsqrtf(ss * (1.f / 64.f) + EPS) * 0.125f;
        const f32x4 w0 = *(const f32x4*)(qw + 8 * q), w1 = *(const f32x4*)(qw + 8 * q + 4), w2 = *(const f32x4*)(qw + 32 + 8 * q), w3 = *(const f32x4*)(qw + 36 + 8 * q);
        const f32x4 a0 = {x[0] * sc * w0[0], x[1] * sc * w0[1], x[2] * sc * w0[2], x[3] * sc * w0[3]}, a1 = {x[4] * sc * w1[0], x[5] * sc * w1[1], x[6] * sc * w1[2], x[7] * sc * w1[3]};
        const f32x4 b0 = {x[8] * sc * w2[0], x[9] * sc * w2[1], x[10] * sc * w2[2], x[11] * sc * w2[3]}, b1 = {x[12] * sc * w3[0], x[13] * sc * w3[1], x[14] * sc * w3[2], x[15] * sc * w3[3]};
        qf[0] = cvt8(a0, a1); qf[1] = cvt8(b0, b1);
    }
    f32x4 s[9];
#pragma unroll
    for (int kt = 0; kt < 9; ++kt) {
        if (kt == 4) __builtin_amdgcn_sched_barrier(0);
        s[kt] = (f32x4){0.f, 0.f, 0.f, 0.f};
#pragma unroll
        for (int ks = 0; ks < 2; ++ks) { const bf16x8 kf = *(const LAS bf16x8*)(Ks + (jj0 + 16 * kt + r) * 72 + 32 * ks + 8 * q);
            s[kt] = __builtin_amdgcn_mfma_f32_16x16x32_bf16(kf, qf[ks], s[kt], 0, 0, 0); }
    }
    __builtin_amdgcn_sched_barrier(0);
    float mx = sink;
#pragma unroll
    for (int kt = 0; kt < 9; ++kt)
#pragma unroll
        for (int j = 0; j < 4; ++j) { const int kl = 16 * kt + 4 * q + j, rel = relbase - kl; const bool valid = (rel >= 0) && (rel < 128) && (kl >= kmin) && (kl < kmax);
            const float v = valid ? s[kt][j] - slope * (float)rel : -1e30f; s[kt][j] = v; mx = fmaxf(mx, v); }
    mx = fmaxf(mx, shx(mx, 16, lane)); mx = fmaxf(mx, shx(mx, 32, lane));
    float den = 0.f;
#pragma unroll
    for (int kt = 0; kt < 9; ++kt)
#pragma unroll
        for (int j = 0; j < 4; ++j) { const float p = (s[kt][j] > -1e29f) ? __expf(s[kt][j] - mx) : 0.f; s[kt][j] = p; den += p; }
    den += shx(den, 16, lane); den += shx(den, 32, lane);
    den += __expf(sink - mx);
    const float inv = 1.f / den;
    __builtin_amdgcn_sched_barrier(0);
    f32x4 o[4];
#pragma unroll
    for (int dt = 0; dt < 4; ++dt) o[dt] = (f32x4){0.f, 0.f, 0.f, 0.f};
#pragma unroll
    for (int kk = 0; kk < 5; ++kk) {
        if (kk == 2) __builtin_amdgcn_sched_barrier(0);
        const f32x4 z4 = {0.f, 0.f, 0.f, 0.f};
        const bf16x8 pf = cvt8(s[2 * kk], (2 * kk + 1 < 9) ? s[2 * kk + 1 < 9 ? 2 * kk + 1 : 8] : z4);
#pragma unroll
        for (int dt = 0; dt < 4; ++dt) {
            const LAS bf16_t* vp = VT + (16 * dt + r) * 264 + jj0 + 32 * kk + 4 * q;
            const u32x2 lo = *(const LAS u32x2*)vp; u32x2 hi = {0u, 0u};
            if (2 * kk + 1 < 9) hi = *(const LAS u32x2*)(vp + 16);
            u32x4 w; w.x = lo.x; w.y = lo.y; w.z = hi.x; w.w = hi.y;
            o[dt] = __builtin_amdgcn_mfma_f32_16x16x32_bf16(__builtin_bit_cast(bf16x8, w), pf, o[dt], 0, 0, 0);
        }
    }
#pragma unroll
    for (int dt = 0; dt < 4; ++dt) { u32x2 w; w.x = pk2(o[dt][0] * inv, o[dt][1] * inv); w.y = pk2(o[dt][2] * inv, o[dt][3] * inv); *(u32x2*)(out + 16 * dt + 4 * q) = w; }
}

__device__ __forceinline__ void ssd_prep_unit(const Params& P, LAS unsigned char* lds, int l, int ci, int g) {
    const int tid = opaque_tid(P.pad), lane = tid & 63, wave = tid >> 6;
    const bf16_t* PROJ = (const bf16_t*)(P.ws + WS_PROJ);
    const float* DT = (const float*)(P.ws + WS_DT);
    float* AC = (float*)(P.ws + WS_AC); float* CD = (float*)(P.ws + WS_CD);
    bf16_t* XTG = (bf16_t*)(P.ws + WS_XTG); bf16_t* BCN = (bf16_t*)(P.ws + WS_BCN); float* ST = (float*)(P.ws + WS_ST);
    LAS bf16_t* XTs = (LAS bf16_t*)lds;
    LAS bf16_t* BT = (LAS bf16_t*)(lds + 69632);
    LAS float* WG = (LAS float*)(lds + 104448);
    const int r0 = ci * 128, c = ci & 63;
    const int cp = tid & 255, th = tid >> 8, lc = 2 * cp;
    int xc; if (lc < 256) xc = g * 256 + lc; else if (lc < 384) xc = 512 + g * 128 + (lc - 256); else xc = 768 + g * 128 + (lc - 384);
    const int t0 = 64 * th;
    const bf16_t* src = PROJ + (size_t)(r0 + t0) * NPROJ + PC_XBC + xc;
    unsigned raw[64];
#pragma unroll
    for (int i = 0; i < 64; ++i) raw[i] = *(const unsigned*)(src + (size_t)i * NPROJ);
    if (wave < 4) {
        const int h = 4 * g + wave; const float a = -__expf(P.in[I_ALOG][l * 8 + h]);
        const float d0 = DT[(size_t)(r0 + lane) * 8 + h], d1 = DT[(size_t)(r0 + 64 + lane) * 8 + h];
        float v0 = d0 * a, v1 = d1 * a;
#pragma unroll
        for (int o = 1; o < 64; o <<= 1) { const int src = lane >= o ? lane - o : lane; const float t0 = shi(v0, src), t1 = shi(v1, src); if (lane >= o) { v0 += t0; v1 += t1; } }
        const float tot0 = shi(v0, 63); v1 += tot0;
        const float last = shi(v1, 63);
        AC[(size_t)(r0 + lane) * 8 + h] = v0; AC[(size_t)(r0 + 64 + lane) * 8 + h] = v1;
        WG[wave * 128 + lane] = __expf(last - v0) * d0; WG[wave * 128 + 64 + lane] = __expf(last - v1) * d1;
        if (lane == 0) CD[ci * 8 + h] = __expf(last);
    }
    __syncthreads();
    {
        const float* cw = P.in[I_CW] + (size_t)l * 4 * 1024 + xc; const float* cb = P.in[I_CB] + (size_t)l * 1024 + xc;
        const f32x2 w0 = *(const f32x2*)cw, w1 = *(const f32x2*)(cw + 1024), w2 = *(const f32x2*)(cw + 2048), w3 = *(const f32x2*)(cw + 3072), bb = *(const f32x2*)cb;
        f32x2 h0 = {0.f, 0.f}, h1 = {0.f, 0.f}, h2 = {0.f, 0.f};
        if (!(c == 0 && th == 0)) {
            const unsigned a = *(const unsigned*)(src - 3 * NPROJ), b = *(const unsigned*)(src - 2 * NPROJ), d = *(const unsigned*)(src - NPROJ);
            h0 = (f32x2){bf2f(a & 0xffffu), bf2f(a >> 16)}; h1 = (f32x2){bf2f(b & 0xffffu), bf2f(b >> 16)}; h2 = (f32x2){bf2f(d & 0xffffu), bf2f(d >> 16)};
        }
        const int hl = lc >> 6;
#pragma unroll
        for (int tb = 0; tb < 8; ++tb) {
            float o0[8], o1[8];
#pragma unroll
            for (int i = 0; i < 8; ++i) {
                const int t = t0 + 8 * tb + i;
                const unsigned a = raw[8 * tb + i];
                const f32x2 cur = {bf2f(a & 0xffffu), bf2f(a >> 16)};
                const f32x2 cv = w0 * h0 + w1 * h1 + w2 * h2 + w3 * cur + bb;
                h0 = h1; h1 = h2; h2 = cur;
                const float y0 = silu_f(cv[0]), y1 = silu_f(cv[1]);
                if (lc < 256) { o0[i] = y0; o1[i] = y1; }
                else { o0[i] = y0; o1[i] = y1; *(unsigned*)(BCN + (size_t)(r0 + t) * 512 + (lc < 384 ? g * 128 + (lc - 256) : 256 + g * 128 + (lc - 384))) = pk2(y0, y1); }
            }
            const int tt = t0 + 8 * tb;
            if (lc < 256) {
                u32x4 u0, u1; u0.x = pk2(o0[0], o0[1]); u0.y = pk2(o0[2], o0[3]); u0.z = pk2(o0[4], o0[5]); u0.w = pk2(o0[6], o0[7]);
                u1.x = pk2(o1[0], o1[1]); u1.y = pk2(o1[2], o1[3]); u1.z = pk2(o1[4], o1[5]); u1.w = pk2(o1[6], o1[7]);
                bf16_t* xg = XTG + ((size_t)ci * 512 + g * 256 + lc) * 128 + tt;
                *(u32x4*)xg = u0; *(u32x4*)(xg + 128) = u1;
                float s0[8], s1[8];
#pragma unroll
                for (int i = 0; i < 8; ++i) { const float w = WG[hl * 128 + tt + i]; s0[i] = o0[i] * w; s1[i] = o1[i] * w; }
                u0.x = pk2(s0[0], s0[1]); u0.y = pk2(s0[2], s0[3]); u0.z = pk2(s0[4], s0[5]); u0.w = pk2(s0[6], s0[7]);
                u1.x = pk2(s1[0], s1[1]); u1.y = pk2(s1[2], s1[3]); u1.z = pk2(s1[4], s1[5]); u1.w = pk2(s1[6], s1[7]);
                *(LAS u32x4*)(XTs + lc * 136 + tt) = u0; *(LAS u32x4*)(XTs + (lc + 1) * 136 + tt) = u1;
            } else if (lc < 384) {
                u32x4 u0, u1; u0.x = pk2(o0[0], o0[1]); u0.y = pk2(o0[2], o0[3]); u0.z = pk2(o0[4], o0[5]); u0.w = pk2(o0[6], o0[7]);
                u1.x = pk2(o1[0], o1[1]); u1.y = pk2(o1[2], o1[3]); u1.z = pk2(o1[4], o1[5]); u1.w = pk2(o1[6], o1[7]);
                *(LAS u32x4*)(BT + (lc - 256) * 136 + tt) = u0; *(LAS u32x4*)(BT + (lc - 255) * 136 + tt) = u1;
            }
        }
        if (c == 63 && th == 1) {
            float* o = P.out + O_PCONV + ((size_t)(l * 4 + (ci >> 6)) * 3) * 1024 + xc;
            *(f32x2*)o = h0; *(f32x2*)(o + 1024) = h1; *(f32x2*)(o + 2048) = h2;
        }
    }
    __syncthreads();
    {
        const int hl = wave >> 1, ph = wave & 1, r = lane & 15, q = lane >> 4;
        f32x4 acc[2][8];
#pragma unroll
        for (int mt = 0; mt < 2; ++mt)
#pragma unroll
            for (int nt = 0; nt < 8; ++nt) acc[mt][nt] = (f32x4){0.f, 0.f, 0.f, 0.f};
#pragma unroll
        for (int ks = 0; ks < 4; ++ks) {
            bf16x8 xf[2];
#pragma unroll
            for (int mt = 0; mt < 2; ++mt) xf[mt] = *(const LAS bf16x8*)(XTs + (hl * 64 + 32 * ph + 16 * mt + r) * 136 + 32 * ks + 8 * q);
#pragma unroll
            for (int nt = 0; nt < 8; ++nt) { const bf16x8 bf = *(const LAS bf16x8*)(BT + (16 * nt + r) * 136 + 32 * ks + 8 * q);
#pragma unroll
                for (int mt = 0; mt < 2; ++mt) acc[mt][nt] = __builtin_amdgcn_mfma_f32_16x16x32_bf16(bf, xf[mt], acc[mt][nt], 0, 0, 0); }
        }
        float* sp = ST + ((size_t)(ci * 8 + 4 * g + hl) * 64) * 128;
#pragma unroll
        for (int mt = 0; mt < 2; ++mt)
#pragma unroll
            for (int nt = 0; nt < 8; ++nt) *(f32x4*)(sp + (size_t)(32 * ph + 16 * mt + r) * 128 + 16 * nt + 4 * q) = acc[mt][nt];
    }
    __syncthreads();
}

__device__ __forceinline__ void attn_prompt_unit(const Params& P, LAS unsigned char* lds, int l, int b, int qb, int kvh) {
    const int tid = opaque_tid(P.pad), lane = tid & 63, wave = tid >> 6;
    const bf16_t* PROJ = (const bf16_t*)(P.ws + WS_PROJ); bf16_t* YCAT = (bf16_t*)(P.ws + WS_YCAT);
    LAS bf16_t* Ks = (LAS bf16_t*)lds;
    LAS bf16_t* VT = (LAS bf16_t*)(lds + 36864);
    const int r1 = b * 8192 + qb * 128;
    u32x4 qa[4], qb4[4];
    {
        const int g = wave >> 1, qh = wave & 1, r = lane & 15, q = lane >> 4, head = kvh * 4 + g;
#pragma unroll
        for (int it = 0; it < 4; ++it) { const bf16_t* qp = PROJ + (size_t)(r1 + 64 * qh + 16 * it + r) * NPROJ + PC_Q + head * 64;
            qa[it] = *(const u32x4*)(qp + 8 * q); qb4[it] = *(const u32x4*)(qp + 32 + 8 * q); }
    }
    {
        const int key = tid >> 1, half = tid & 1; const int row = r1 - 128 + key; const bool ok = (qb > 0) || (key >= 128);
        float kx[32], vx[32];
        if (ok) {
            const bf16_t* kp = PROJ + (size_t)row * NPROJ + PC_K + kvh * 64 + 32 * half; const bf16_t* vp = PROJ + (size_t)row * NPROJ + PC_V + kvh * 64 + 32 * half;
#pragma unroll
            for (int i = 0; i < 4; ++i) { const u32x4 a = *(const u32x4*)(kp + 8 * i), v = *(const u32x4*)(vp + 8 * i);
#pragma unroll
                for (int e = 0; e < 4; ++e) { kx[8 * i + 2 * e] = bf2f(a[e] & 0xffffu); kx[8 * i + 2 * e + 1] = bf2f(a[e] >> 16); vx[8 * i + 2 * e] = bf2f(v[e] & 0xffffu); vx[8 * i + 2 * e + 1] = bf2f(v[e] >> 16); } }
        } else {
#pragma unroll
            for (int i = 0; i < 32; ++i) { kx[i] = 0.f; vx[i] = 0.f; }
        }
        float ss = 0.f;
#pragma unroll
        for (int i = 0; i < 32; ++i) ss += kx[i] * kx[i];
        ss += shx(ss, 1, lane);
        const float rs = rsqrtf(ss * (1.f / 64.f) + EPS);
        const float* kw = P.in[I_KN] + l * 64 + 32 * half;
#pragma unroll
        for (int i = 0; i < 32; ++i) kx[i] = kx[i] * rs * kw[i];
#pragma unroll
        for (int i = 0; i < 4; ++i) { u32x4 w; w.x = pk2(kx[8 * i], kx[8 * i + 1]); w.y = pk2(kx[8 * i + 2], kx[8 * i + 3]); w.z = pk2(kx[8 * i + 4], kx[8 * i + 5]); w.w = pk2(kx[8 * i + 6], kx[8 * i + 7]);
            *(LAS u32x4*)(Ks + key * 72 + 32 * half + 8 * i) = w; }
#pragma unroll
        for (int i = 0; i < 32; ++i) VT[(32 * half + i) * 264 + key] = (bf16_t)(pk2(vx[i], 0.f) & 0xffffu);
        if (qb == 63 && key >= 128) {
            float* ko = P.out + O_PK + (((size_t)(l * 4 + b) * 128 + (key - 128)) * 2 + kvh) * 64 + 32 * half; float* vo = P.out + O_PV + (((size_t)(l * 4 + b) * 128 + (key - 128)) * 2 + kvh) * 64 + 32 * half;
#pragma unroll
            for (int i = 0; i < 8; ++i) { *(f32x4*)(ko + 4 * i) = (f32x4){kx[4 * i], kx[4 * i + 1], kx[4 * i + 2], kx[4 * i + 3]}; *(f32x4*)(vo + 4 * i) = (f32x4){vx[4 * i], vx[4 * i + 1], vx[4 * i + 2], vx[4 * i + 3]}; }
        }
    }
    __syncthreads();
    {
        const int g = wave >> 1, qh = wave & 1, r = lane & 15, q = lane >> 4, head = kvh * 4 + g;
        const float slope = exp2f(-(float)(head + 1)), sink = P.in[I_SINK][l * 8 + head];
#pragma unroll
        for (int it = 0; it < 4; ++it) {
            const int i0 = 64 * qh + 16 * it; const int row = r1 + i0 + r;
            __builtin_amdgcn_sched_barrier(0);
            attn_tile(qa[it], qb4[it], P.in[I_QN] + l * 64, Ks, VT, i0, r + 128, (qb > 0) ? 0 : 128 - i0, 144, slope, sink,
                      YCAT + (size_t)row * DM + 512 + head * 64, r, q);
        }
    }
    __syncthreads();
}

__device__ __forceinline__ void ssd_sample_unit(const Params& P, LAS unsigned char* lds, int l, int b, int g) {
    const int tid = opaque_tid(P.pad);
    const bf16_t* PROJ = (const bf16_t*)(P.ws + WS_PROJ); const float* DT = (const float*)(P.ws + WS_DT); bf16_t* YCAT = (bf16_t*)(P.ws + WS_YCAT);
    LAS float* XV = (LAS float*)lds;
    LAS float* YZ = (LAS float*)(lds + 8192);
    LAS float* RS = (LAS float*)(lds + 12288);
    const int rs0 = MP + 4 * b;
    {
        const int lc = tid; int xc; if (lc < 256) xc = g * 256 + lc; else if (lc < 384) xc = 512 + g * 128 + (lc - 256); else xc = 768 + g * 128 + (lc - 384);
        const float* cw = P.in[I_CW] + (size_t)l * 4 * 1024 + xc; const float w0 = cw[0], w1 = cw[1024], w2 = cw[2048], w3 = cw[3072], bb = P.in[I_CB][l * 1024 + xc];
        const float* sp = P.in[I_SCONV] + ((size_t)(l * 128 + b) * 3) * 1024 + xc;
        float h0 = sp[0], h1 = sp[1024], h2 = sp[2048];
#pragma unroll
        for (int t = 0; t < 4; ++t) {
            const float cur = bf2f(PROJ[(size_t)(rs0 + t) * NPROJ + PC_XBC + xc]);
            const float cv = w0 * h0 + w1 * h1 + w2 * h2 + w3 * cur + bb;
            h0 = h1; h1 = h2; h2 = cur;
            XV[t * 512 + lc] = silu_f(cv);
        }
        float* o = P.out + O_SCONV + ((size_t)(l * 128 + b) * 3) * 1024 + xc; o[0] = h0; o[1024] = h1; o[2048] = h2;
    }
    __syncthreads();
    {
        const int hl = tid >> 7, p = (tid & 127) >> 1, nh = tid & 1, h = 4 * g + hl, lane = tid & 63;
        const float a = -__expf(P.in[I_ALOG][l * 8 + h]), dsk = P.in[I_DSKIP][l * 8 + h];
        const float* sin_ = P.in[I_SSM] + (((size_t)(l * 128 + b) * 8 + h) * 64 + p) * 128 + 64 * nh;
        float* sout = P.out + O_SSSM + (((size_t)(l * 128 + b) * 8 + h) * 64 + p) * 128 + 64 * nh;
        f32x4 st[16];
#pragma unroll
        for (int i = 0; i < 16; ++i) st[i] = *(const f32x4*)(sin_ + 4 * i);
        float dtv[4], zv[4];
#pragma unroll
        for (int t = 0; t < 4; ++t) { dtv[t] = DT[(size_t)(rs0 + t) * 8 + h]; zv[t] = bf2f(PROJ[(size_t)(rs0 + t) * NPROJ + PC_Z + h * 64 + p]); }
#pragma unroll
        for (int t = 0; t < 4; ++t) {
            const float dt = dtv[t], dA = __expf(dt * a), x = XV[t * 512 + hl * 64 + p], xdt = x * dt;
            float y = 0.f;
#pragma unroll
            for (int i = 0; i < 16; ++i) { const f32x4 bv = *(const LAS f32x4*)(XV + t * 512 + 256 + 64 * nh + 4 * i), cv = *(const LAS f32x4*)(XV + t * 512 + 384 + 64 * nh + 4 * i);
                st[i] = st[i] * dA + xdt * bv; y += (st[i][0] * cv[0] + st[i][1] * cv[1]) + (st[i][2] * cv[2] + st[i][3] * cv[3]); }
            y += shx(y, 1, lane);
            y += dsk * x;
            const float z = zv[t];
            if (nh == 0) YZ[t * 256 + hl * 64 + p] = y * silu_f(z);
        }
#pragma unroll
        for (int i = 0; i < 16; ++i) *(f32x4*)(sout + 4 * i) = st[i];
    }
    __syncthreads();
    {
        const int wave = tid >> 6, lane = tid & 63;
        if (wave < 4) { float s = 0.f;
#pragma unroll
            for (int i = 0; i < 4; ++i) { const float v = YZ[wave * 256 + lane + 64 * i]; s += v * v; }
            s = wave_sum(s, lane); if (lane == 0) RS[wave] = rsqrtf(s * (1.f / 256.f) + EPS); }
    }
    __syncthreads();
    for (int e = tid; e < 1024; e += 512) { const int t = e >> 8, ch = e & 255;
        YCAT[(size_t)(rs0 + t) * DM + g * 256 + ch] = (bf16_t)(pk2(YZ[e] * RS[t] * P.in[I_SNORM][l * 512 + g * 256 + ch], 0.f) & 0xffffu); }
    __syncthreads();
}

__device__ __forceinline__ void attn_sample_unit(const Params& P, LAS unsigned char* lds, int l, int b, int kvh) {
    const int tid = opaque_tid(P.pad), lane = tid & 63, wave = tid >> 6;
    const bf16_t* PROJ = (const bf16_t*)(P.ws + WS_PROJ); bf16_t* YCAT = (bf16_t*)(P.ws + WS_YCAT);
    LAS bf16_t* Ks = (LAS bf16_t*)lds; LAS bf16_t* VT = (LAS bf16_t*)(lds + 36864);
    const int rs0 = MP + 4 * b;
    {
        const int key = tid >> 2, qt = tid & 3;
        const float* kp = P.in[I_CK] + (((size_t)(l * 128 + b) * 128 + key) * 2 + kvh) * 64 + 16 * qt; const float* vp = P.in[I_CV] + (((size_t)(l * 128 + b) * 128 + key) * 2 + kvh) * 64 + 16 * qt;
        f32x4 k4[4], v4[4];
#pragma unroll
        for (int i = 0; i < 4; ++i) { k4[i] = *(const f32x4*)(kp + 4 * i); v4[i] = *(const f32x4*)(vp + 4 * i); }
        *(LAS u32x4*)(Ks + key * 72 + 16 * qt) = __builtin_bit_cast(u32x4, cvt8(k4[0], k4[1])); *(LAS u32x4*)(Ks + key * 72 + 16 * qt + 8) = __builtin_bit_cast(u32x4, cvt8(k4[2], k4[3]));
#pragma unroll
        for (int i = 0; i < 4; ++i)
#pragma unroll
            for (int e = 0; e < 4; ++e) VT[(16 * qt + 4 * i + e) * 264 + key] = (bf16_t)(pk2(v4[i][e], 0.f) & 0xffffu);
        if (key >= 4) {
            float* ko = P.out + O_SK + (((size_t)(l * 128 + b) * 128 + (key - 4)) * 2 + kvh) * 64 + 16 * qt; float* vo = P.out + O_SV + (((size_t)(l * 128 + b) * 128 + (key - 4)) * 2 + kvh) * 64 + 16 * qt;
#pragma unroll
            for (int i = 0; i < 4; ++i) { *(f32x4*)(ko + 4 * i) = k4[i]; *(f32x4*)(vo + 4 * i) = v4[i]; }
        }
    }
    if (tid < 64) {
        const int t = tid >> 4, d4 = (tid & 15) * 4;
        const bf16_t* kp = PROJ + (size_t)(rs0 + t) * NPROJ + PC_K + kvh * 64 + d4; const bf16_t* vp = PROJ + (size_t)(rs0 + t) * NPROJ + PC_V + kvh * 64 + d4;
        const u32x2 a = *(const u32x2*)kp, v = *(const u32x2*)vp;
        float kx[4] = {bf2f(a.x & 0xffffu), bf2f(a.x >> 16), bf2f(a.y & 0xffffu), bf2f(a.y >> 16)}, vx[4] = {bf2f(v.x & 0xffffu), bf2f(v.x >> 16), bf2f(v.y & 0xffffu), bf2f(v.y >> 16)};
        float ss = (kx[0] * kx[0] + kx[1] * kx[1]) + (kx[2] * kx[2] + kx[3] * kx[3]);
        ss += shx(ss, 1, lane); ss += shx(ss, 2, lane); ss += shx(ss, 4, lane); ss += shx(ss, 8, lane);
        const float rs = rsqrtf(ss * (1.f / 64.f) + EPS);
        const f32x4 kw = *(const f32x4*)(P.in[I_KN] + l * 64 + d4);
#pragma unroll
        for (int e = 0; e < 4; ++e) kx[e] = kx[e] * rs * kw[e];
        u32x2 w; w.x = pk2(kx[0], kx[1]); w.y = pk2(kx[2], kx[3]); *(LAS u32x2*)(Ks + (128 + t) * 72 + d4) = w;
#pragma unroll
        for (int e = 0; e < 4; ++e) VT[(d4 + e) * 264 + 128 + t] = (bf16_t)(pk2(vx[e], 0.f) & 0xffffu);
        float* ko = P.out + O_SK + (((size_t)(l * 128 + b) * 128 + (124 + t)) * 2 + kvh) * 64 + d4; float* vo = P.out + O_SV + (((size_t)(l * 128 + b) * 128 + (124 + t)) * 2 + kvh) * 64 + d4;
        *(f32x4*)ko = (f32x4){kx[0], kx[1], kx[2], kx[3]}; *(f32x4*)vo = (f32x4){vx[0], vx[1], vx[2], vx[3]};
    } else if (tid < 128) {
        const int e = tid - 64;
        for (int i = e; i < 12 * 64; i += 64) Ks[(132 + i / 64) * 72 + (i & 63)] = 0;
        for (int i = e; i < 64 * 12; i += 64) VT[(i / 12) * 264 + 132 + (i % 12)] = 0;
    }
    __syncthreads();
    if (wave == 0) {
        const int r = lane & 15, q = lane >> 4, g = r >> 2, t = r & 3, head = kvh * 4 + g;
        const float slope = exp2f(-(float)(head + 1)), sink = P.in[I_SINK][l * 8 + head];
        const bf16_t* qp = PROJ + (size_t)(rs0 + t) * NPROJ + PC_Q + head * 64;
        attn_tile(*(const u32x4*)(qp + 8 * q), *(const u32x4*)(qp + 32 + 8 * q), P.in[I_QN] + l * 64, Ks, VT, 0, t + 128, 0, 132, slope, sink,
                  YCAT + (size_t)(rs0 + t) * DM + 512 + head * 64, r, q);
    }
    __syncthreads();
}

__device__ __forceinline__ void phase_scan(const Params& P, int l) {
    const float* ST = (const float*)(P.ws + WS_ST); const float* CD = (const float*)(P.ws + WS_CD); bf16_t* PB = (bf16_t*)(P.ws + WS_PSTB);
    for (int idx = blockIdx.x * 512 + opaque_tid(P.pad); idx < 131072; idx += gridDim.x * 512) {
        const int b = idx >> 15, rem = idx & 32767, h = rem >> 12, e2 = rem & 4095;
        f32x2 carry = {0.f, 0.f};
        for (int c0 = 0; c0 < 64; c0 += 16) {
            f32x2 v[16]; float dc[16];
#pragma unroll
            for (int i = 0; i < 16; ++i) { v[i] = *(const f32x2*)(ST + ((size_t)((b * 64 + c0 + i) * 8 + h)) * 8192 + 2 * e2); dc[i] = CD[(b * 64 + c0 + i) * 8 + h]; }
#pragma unroll
            for (int i = 0; i < 16; ++i) { *(unsigned*)(PB + ((size_t)((b * 64 + c0 + i) * 8 + h)) * 8192 + 2 * e2) = pk2(carry[0], carry[1]); carry = carry * dc[i] + v[i]; }
        }
        *(f32x2*)(P.out + O_PSSM + ((size_t)((l * 4 + b) * 8 + h)) * 8192 + 2 * e2) = carry;
    }
}

__device__ __forceinline__ void ssd_out_unit(const Params& P, LAS unsigned char* lds, int l, int ci, int g) {
    const int tid = opaque_tid(P.pad), lane = tid & 63, wave = tid >> 6;
    const bf16_t* PROJ = (const bf16_t*)(P.ws + WS_PROJ); const float* DT = (const float*)(P.ws + WS_DT); const float* AC = (const float*)(P.ws + WS_AC);
    const bf16_t* XTG = (const bf16_t*)(P.ws + WS_XTG); const bf16_t* BCN = (const bf16_t*)(P.ws + WS_BCN); const bf16_t* PB = (const bf16_t*)(P.ws + WS_PSTB);
    bf16_t* YCAT = (bf16_t*)(P.ws + WS_YCAT);
    LAS bf16_t* XT = (LAS bf16_t*)lds;
    LAS bf16_t* Bn = (LAS bf16_t*)(lds + 69632);
    LAS bf16_t* Cn = (LAS bf16_t*)(lds + 104448);
    LAS float* ACs = (LAS float*)(lds + 139264);
    LAS float* DTs = (LAS float*)(lds + 141312);
    const int r0 = ci * 128;
    for (int e = tid; e < 4096; e += 512) { const int row = e >> 4, pc = e & 15; *(LAS u32x4*)(XT + row * 136 + 8 * pc) = *(const u32x4*)(XTG + ((size_t)ci * 512 + g * 256 + row) * 128 + 8 * pc); }
    for (int e = tid; e < 2048; e += 512) { const int row = e >> 4, pc = e & 15;
        *(LAS u32x4*)(Bn + row * 136 + 8 * pc) = *(const u32x4*)(BCN + (size_t)(r0 + row) * 512 + g * 128 + 8 * pc);
        *(LAS u32x4*)(Cn + row * 136 + 8 * pc) = *(const u32x4*)(BCN + (size_t)(r0 + row) * 512 + 256 + g * 128 + 8 * pc); }
    { const int hl = tid >> 7, t = tid & 127; ACs[hl * 128 + t] = AC[(size_t)(r0 + t) * 8 + 4 * g + hl]; DTs[hl * 128 + t] = DT[(size_t)(r0 + t) * 8 + 4 * g + hl]; }
    __syncthreads();
    {
        const int nt = wave, r = lane & 15, q = lane >> 4, lrow = 16 * nt + r;
        bf16x8 cf[4];
#pragma unroll
        for (int ks = 0; ks < 4; ++ks) cf[ks] = *(const LAS bf16x8*)(Cn + lrow * 136 + 32 * ks + 8 * q);
        f32x4 gt[8];
#pragma unroll
        for (int st = 0; st < 8; ++st) {
            gt[st] = (f32x4){0.f, 0.f, 0.f, 0.f};
            if ((st & 1) == 0) __builtin_amdgcn_sched_barrier(0);
            if (st <= nt) {
#pragma unroll
                for (int ks = 0; ks < 4; ++ks) gt[st] = __builtin_amdgcn_mfma_f32_16x16x32_bf16(*(const LAS bf16x8*)(Bn + (16 * st + r) * 136 + 32 * ks + 8 * q), cf[ks], gt[st], 0, 0, 0);
            }
        }
        float ss = 0.f;
        const int grow = r0 + lrow;
        __syncthreads();
        LAS bf16_t* YL = (LAS bf16_t*)(lds + 69632);
#pragma unroll 1
        for (int hl = 0; hl < 4; ++hl) {
            const int h = 4 * g + hl;
            __builtin_amdgcn_sched_barrier(0);
            f32x4 acc[4], aco[4];
#pragma unroll
            for (int mt = 0; mt < 4; ++mt) { acc[mt] = (f32x4){0.f, 0.f, 0.f, 0.f}; aco[mt] = (f32x4){0.f, 0.f, 0.f, 0.f}; }
            const bf16_t* pv = PB + ((size_t)(ci * 8 + h) * 64) * 128;
            bf16x8 pf[2][4];
#pragma unroll
            for (int ks = 0; ks < 2; ++ks)
#pragma unroll
                for (int mt = 0; mt < 4; ++mt) pf[ks][mt] = *(const bf16x8*)(pv + (size_t)(16 * mt + r) * 128 + 32 * ks + 8 * q);
            u32x2 zzv[4];
#pragma unroll
            for (int mt = 0; mt < 4; ++mt) zzv[mt] = *(const u32x2*)(PROJ + (size_t)grow * NPROJ + PC_Z + h * 64 + 16 * mt + 4 * q);
            const float dsk = P.in[I_DSKIP][l * 8 + h];
            const float al = ACs[hl * 128 + lrow], el = __expf(al);
#pragma unroll
            for (int kk = 0; kk < 4; ++kk) {
                __builtin_amdgcn_sched_barrier(0);
                if (kk == 2) {
#pragma unroll
                    for (int ks = 0; ks < 2; ++ks)
#pragma unroll
                        for (int mt = 0; mt < 4; ++mt) aco[mt] = __builtin_amdgcn_mfma_f32_16x16x32_bf16(pf[ks][mt], cf[ks], aco[mt], 0, 0, 0);
#pragma unroll
                    for (int ks = 0; ks < 2; ++ks)
#pragma unroll
                        for (int mt = 0; mt < 4; ++mt) pf[ks][mt] = *(const bf16x8*)(pv + (size_t)(16 * mt + r) * 128 + 32 * (ks + 2) + 8 * q);
                    __builtin_amdgcn_sched_barrier(0);
                }
                if (2 * kk <= nt) {
                    f32x4 wv[2];
#pragma unroll
                    for (int hf = 0; hf < 2; ++hf) { const int st = 2 * kk + hf;
                        const f32x4 as = *(const LAS f32x4*)(ACs + hl * 128 + 16 * st + 4 * q), ds = *(const LAS f32x4*)(DTs + hl * 128 + 16 * st + 4 * q);
#pragma unroll
                        for (int j = 0; j < 4; ++j) { const int s = 16 * st + 4 * q + j; wv[hf][j] = (s <= lrow) ? gt[st][j] * __expf(al - as[j]) * ds[j] : 0.f; } }
                    const bf16x8 wf = cvt8(wv[0], wv[1]);
#pragma unroll
                    for (int mt = 0; mt < 4; ++mt) { const LAS bf16_t* xp = XT + (hl * 64 + 16 * mt + r) * 136 + 32 * kk + 4 * q;
                        const u32x2 lo = *(const LAS u32x2*)xp, hi = *(const LAS u32x2*)(xp + 16); u32x4 w; w.x = lo.x; w.y = lo.y; w.z = hi.x; w.w = hi.y;
                        acc[mt] = __builtin_amdgcn_mfma_f32_16x16x32_bf16(__builtin_bit_cast(bf16x8, w), wf, acc[mt], 0, 0, 0); }
                }
            }
            __builtin_amdgcn_sched_barrier(0);
#pragma unroll
            for (int ks = 0; ks < 2; ++ks)
#pragma unroll
                for (int mt = 0; mt < 4; ++mt) aco[mt] = __builtin_amdgcn_mfma_f32_16x16x32_bf16(pf[ks][mt], cf[ks + 2], aco[mt], 0, 0, 0);
#pragma unroll
            for (int mt = 0; mt < 4; ++mt) acc[mt] = acc[mt] + aco[mt] * el;
#pragma unroll
            for (int mt = 0; mt < 4; ++mt) { const u32x2 zz = zzv[mt];
                const float z[4] = {bf2f(zz.x & 0xffffu), bf2f(zz.x >> 16), bf2f(zz.y & 0xffffu), bf2f(zz.y >> 16)};
                float yv[4];
#pragma unroll
                for (int j = 0; j < 4; ++j) { const float x = bf2f(XT[(hl * 64 + 16 * mt + 4 * q + j) * 136 + lrow]); const float y = (acc[mt][j] + dsk * x) * silu_f(z[j]); yv[j] = y; ss += y * y; }
                u32x2 yo; yo.x = pk2(yv[0], yv[1]); yo.y = pk2(yv[2], yv[3]); *(LAS u32x2*)(YL + lrow * 264 + hl * 64 + 16 * mt + 4 * q) = yo; }
        }
        ss += shx(ss, 16, lane); ss += shx(ss, 32, lane);
        const float rstd = rsqrtf(ss * (1.f / 256.f) + EPS);
        const float* nw = P.in[I_SNORM] + l * 512 + g * 256;
        const int piece = lane & 31, rsub = lane >> 5;
        const f32x4 w0 = *(const f32x4*)(nw + 8 * piece), w1 = *(const f32x4*)(nw + 8 * piece + 4);
#pragma unroll
        for (int ps = 0; ps < 8; ++ps) {
            const int rr = 2 * ps + rsub; const float rs = shi(rstd, rr);
            const u32x4 yv = *(const LAS u32x4*)(YL + (16 * nt + rr) * 264 + 8 * piece);
            u32x4 o; o.x = pk2(bf2f(yv.x & 0xffffu) * rs * w0[0], bf2f(yv.x >> 16) * rs * w0[1]); o.y = pk2(bf2f(yv.y & 0xffffu) * rs * w0[2], bf2f(yv.y >> 16) * rs * w0[3]);
            o.z = pk2(bf2f(yv.z & 0xffffu) * rs * w1[0], bf2f(yv.z >> 16) * rs * w1[1]); o.w = pk2(bf2f(yv.w & 0xffffu) * rs * w1[2], bf2f(yv.w >> 16) * rs * w1[3]);
            *(u32x4*)(YCAT + (size_t)(r0 + 16 * nt + rr) * DM + g * 256 + 8 * piece) = o;
        }
    }
    __syncthreads();
}

__device__ __forceinline__ void phase_fixup(const Params& P, int l) {
    const bf16_t* UH = (const bf16_t*)(P.ws + WS_UH); bf16_t* G = (bf16_t*)(P.ws + WS_G);
    const float* cw = P.in[I_FCW] + (size_t)l * 3 * NUP; const float* cb = P.in[I_FCB] + (size_t)l * NUP;
    const float* US = (const float*)(P.ws + WS_US);
#pragma unroll 1
    for (int part = 0; part < 2; ++part) {
    if ((part ^ (int)(blockIdx.x & 1)) == 0)
    for (int gi = blockIdx.x; gi < 512; gi += gridDim.x) {
        const bool first = (gi & 127) == 0;
        const bf16_t* cur = UH + (size_t)gi * 4 * NUP; const bf16_t* prv = UH + (size_t)(gi - 1) * 4 * NUP;
        for (int j4 = opaque_tid(P.pad); j4 < DFF / 4; j4 += 512) {
            const int j = 4 * j4;
            f32x4 cvv[2][2];
#pragma unroll
            for (int gv = 0; gv < 2; ++gv) { const int c = j + gv * DFF;
                const f32x4 w0 = *(const f32x4*)(cw + c), w1 = *(const f32x4*)(cw + NUP + c), w2 = *(const f32x4*)(cw + 2 * NUP + c), bb = *(const f32x4*)(cb + c);
                const u32x2 a0 = *(const u32x2*)(cur + c), a1 = *(const u32x2*)(cur + NUP + c);
                u32x2 p2 = {0u, 0u}, p1 = {0u, 0u}; if (!first) { p2 = *(const u32x2*)(prv + 2 * NUP + c); p1 = *(const u32x2*)(prv + 3 * NUP + c); }
                const f32x4 u0 = {bf2f(a0.x & 0xffffu), bf2f(a0.x >> 16), bf2f(a0.y & 0xffffu), bf2f(a0.y >> 16)}, u1 = {bf2f(a1.x & 0xffffu), bf2f(a1.x >> 16), bf2f(a1.y & 0xffffu), bf2f(a1.y >> 16)};
                const f32x4 pm2 = {bf2f(p2.x & 0xffffu), bf2f(p2.x >> 16), bf2f(p2.y & 0xffffu), bf2f(p2.y >> 16)}, pm1 = {bf2f(p1.x & 0xffffu), bf2f(p1.x >> 16), bf2f(p1.y & 0xffffu), bf2f(p1.y >> 16)};
                cvv[0][gv] = w0 * pm2 + w1 * pm1 + w2 * u0 + bb; cvv[1][gv] = w0 * pm1 + w1 * u0 + w2 * u1 + bb; }
#pragma unroll
            for (int rr = 0; rr < 2; ++rr) { u32x2 o; o.x = pk2(silu_f(cvv[rr][0][0]) * cvv[rr][1][0], silu_f(cvv[rr][0][1]) * cvv[rr][1][1]); o.y = pk2(silu_f(cvv[rr][0][2]) * cvv[rr][1][2], silu_f(cvv[rr][0][3]) * cvv[rr][1][3]);
                *(u32x2*)(G + (size_t)(64 * gi + rr) * DFF + j) = o; }
        }
        if ((gi & 127) == 127) { float* o = P.out + O_PFFN + ((size_t)(l * 4 + (gi >> 7)) * 2) * NUP;
            for (int c = opaque_tid(P.pad); c < 2 * NUP; c += 512) o[c] = bf2f(cur[2 * NUP + c]); }
    }
    else
    for (int hb = blockIdx.x; hb < 256; hb += gridDim.x) {
        const int b = hb >> 1, jlo = (hb & 1) * (DFF / 2);
        const float* sp = P.in[I_SFFN] + ((size_t)(l * 128 + b) * 2) * NUP; float* sn = P.out + O_SFFN + ((size_t)(l * 128 + b) * 2) * NUP;
        const float* ub = US + (size_t)(4 * b) * NUP;
        for (int j = jlo + opaque_tid(P.pad); j < jlo + DFF / 2; j += 512) {
            float cv[4][2];
#pragma unroll
            for (int gv = 0; gv < 2; ++gv) { const int c = j + gv * DFF;
                const float w0 = cw[c], w1 = cw[NUP + c], w2 = cw[2 * NUP + c], bb = cb[c];
                const float s0 = sp[c], s1 = sp[NUP + c]; float u0 = 0.f, u1 = 0.f, u2 = 0.f, u3 = 0.f;
#pragma unroll
                for (int k = 0; k < 4; ++k) { const float* uk = ub + (size_t)k * MS * NUP; u0 += uk[c]; u1 += uk[NUP + c]; u2 += uk[2 * NUP + c]; u3 += uk[3 * NUP + c]; }
                cv[0][gv] = w0 * s0 + w1 * s1 + w2 * u0 + bb; cv[1][gv] = w0 * s1 + w1 * u0 + w2 * u1 + bb;
                cv[2][gv] = w0 * u0 + w1 * u1 + w2 * u2 + bb; cv[3][gv] = w0 * u1 + w1 * u2 + w2 * u3 + bb;
                sn[c] = u2; sn[NUP + c] = u3; }
#pragma unroll
            for (int t = 0; t < 4; ++t) G[(size_t)(MP + 4 * b + t) * DFF + j] = (bf16_t)(pk2(silu_f(cv[t][0]) * cv[t][1], 0.f) & 0xffffu);
        }
    }
    }
}

__device__ __forceinline__ void phase_final(const Params& P) {
    const int tid = opaque_tid(P.pad);
    for (int i = blockIdx.x * 512 + tid; i < MS * DM / 4; i += gridDim.x * 512) {
        f32x4 v = *(const f32x4*)((const float*)(P.ws + WS_XS) + 4 * i);
        for (int k = 0; k < 11; ++k) v = v + *(const f32x4*)((const float*)(P.ws + WS_XSL) + (size_t)k * MS * DM + 4 * i);
        *(f32x4*)(P.out + (size_t)MP * DM + 4 * i) = v;
    }
}
#define XB_TMO      128
#define XB_XCNT(j)  (256  + 64 * (j))
#define XB_XSUB(j)  (1280 + 64 * (j))
#define XB_XGEN(j)  (2304 + 64 * (j))
#define XB_TOP      3328
#define XB_TOPGEN   3392
#define XCD_BAR_WORDS 3456
#define XB_SPIN_CAP (1u << 18)


__device__ __forceinline__ unsigned xb_ld(unsigned* p)              { return __hip_atomic_load(p, __ATOMIC_RELAXED, __HIP_MEMORY_SCOPE_AGENT); }
__device__ __forceinline__ unsigned xb_add(unsigned* p, unsigned v) { return __hip_atomic_fetch_add(p, v, __ATOMIC_RELAXED, __HIP_MEMORY_SCOPE_AGENT); }
__device__ __forceinline__ unsigned xb_xcc_id() { return (unsigned)__builtin_amdgcn_s_getreg((3 << 11) | 20) & 0xFu; }
#define XB_SPIN(cond, bar) do { unsigned _sp = 0; while (cond) { __builtin_amdgcn_s_sleep(1); \
    if ((++_sp & 255u) == 0u) { if (xb_ld(&(bar)[XB_TMO])) break; if (_sp > XB_SPIN_CAP) { atomicAdd(&(bar)[XB_TMO], 1u); break; } } } } while (0)

struct XcdBarrier {
    unsigned* bar; unsigned x;
    volatile LAS unsigned* st;
};

__device__ __forceinline__ XcdBarrier xcd_barrier_post(unsigned* bar, volatile LAS unsigned* st, bool t0) {
    XcdBarrier b; b.bar = bar; b.x = xb_xcc_id(); b.st = st;
    if (t0) (void)xb_add(&bar[XB_XCNT(b.x)], 1u);
    return b;
}
__device__ __forceinline__ void xcd_barrier_complete(unsigned* bar, unsigned x, unsigned& nloc, unsigned& nx) {
    const unsigned G = gridDim.x * gridDim.y * gridDim.z;
    unsigned sum, cnt, mine, sp = 0u;
    for (;;) {
        sum = 0u; cnt = 0u; mine = 0u;
#pragma unroll
        for (unsigned j = 0; j < 16; ++j) { const unsigned c = xb_ld(&bar[XB_XCNT(j)]); sum += c; cnt += (c > 0u) ? 1u : 0u; mine = (j == x) ? c : mine; }
        if (sum == G) break;
        __builtin_amdgcn_s_sleep(1);
        if ((++sp & 255u) == 0u) { if (xb_ld(&bar[XB_TMO])) break; if (sp > XB_SPIN_CAP) { atomicAdd(&bar[XB_TMO], 1u); break; } }
    }
    nloc = mine > 0u ? mine : 1u; nx = cnt > 0u ? cnt : 1u;
}

__device__ __forceinline__ void xcd_barrier(const XcdBarrier& b, bool t0) {
    asm volatile("s_waitcnt vmcnt(0)" ::: "memory");
    __syncthreads();
    if (t0) {
        unsigned* bar = b.bar;
        __builtin_amdgcn_s_waitcnt(0);
        unsigned nloc = b.st[0], nx = b.st[1];
        if (nloc == 0u) { xcd_barrier_complete(bar, b.x, nloc, nx); b.st[0] = nloc; b.st[1] = nx; }
        const unsigned old = xb_add(&bar[XB_XSUB(b.x)], 1u);
        const unsigned gen = old / nloc;
        if (old + 1u == (gen + 1u) * nloc) {
            __builtin_amdgcn_fence(__ATOMIC_RELEASE, "agent");
            asm volatile("s_waitcnt vmcnt(0)" ::: "memory");
            const unsigned og = xb_add(&bar[XB_TOP], 1u);
            const unsigned tg = og / nx;
            if (og + 1u == (tg + 1u) * nx) xb_add(&bar[XB_TOPGEN], 1u);
            else XB_SPIN(xb_ld(&bar[XB_TOPGEN]) == tg, bar);
            __builtin_amdgcn_fence(__ATOMIC_ACQUIRE, "agent");
            xb_add(&bar[XB_XGEN(b.x)], 1u);
            asm volatile("s_waitcnt vmcnt(0)" ::: "memory");
        } else {
            XB_SPIN(xb_ld(&bar[XB_XGEN(b.x)]) == gen, bar);
            __builtin_amdgcn_fence(__ATOMIC_ACQUIRE, "agent");
            asm volatile("s_waitcnt vmcnt(0)" ::: "memory");
        }
    }
    __syncthreads();
}


constexpr int N_PHASES = 22;
#ifndef ONLY_K
#define ONLY_K -1
#endif
#ifndef ONLY_U
#define ONLY_U -1
#endif
#define ENU(uu) (ONLY_U < 0 || ONLY_U == (uu))
#define EN(kk) (ONLY_K < 0 || ONLY_K == (kk))
__global__ void __launch_bounds__(512, 2) fwd_megakernel(Params Pk) {
    Params P = Pk; P.pad = __builtin_amdgcn_readfirstlane((int)threadIdx.x & ~63);
    extern __shared__ __attribute__((aligned(16))) unsigned char lds_raw[];
    LAS unsigned char* lds = (LAS unsigned char*)lds_raw;
    cg::grid_group grid = cg::this_grid();
    volatile LAS unsigned* stw = (volatile LAS unsigned*)(lds + LDS_BYTES - 16);
    { const int t = opaque_tid(P.pad); if (t < 4) stw[t] = 0u; }
    __syncthreads();
    const XcdBarrier bar = xcd_barrier_post((unsigned*)(P.ws + WS_CTL), stw, opaque_tid(P.pad) == 0);
    float* X = P.out;
    for (int ph = P.ph_lo; ph < P.ph_hi; ++ph) {
        if (ph == 0) { if (!(blockIdx.x & 1)) { if (EN(10)) phase_weights(P, lds); __syncthreads(); } }
        else if (ph == 21) phase_final(P);
        else {
            int phv = ph, gdim = gridDim.x, bidx = blockIdx.x; asm volatile("" : "+s"(phv), "+s"(gdim), "+s"(bidx));
            const int l = (phv - 1) / 10, k = (phv - 1) % 10;
            void* XB1 = (void*)(P.ws + WS_XB); void* XB2 = (void*)P.out; const float* XS = (const float*)(P.ws + WS_XS);
            const void* xin = (l == 0) ? (const void*)P.in[I_XP] : (const void*)XB2;
            if (k == 0) { if (EN(0)) phase_norm<true>(P, lds, l, xin, l != 0, l == 0 ? P.in[I_XS] : XS, P.in[I_N1] + l * DM, l == 0 ? 0 : 11);
                if (l == 0 && (bidx & 1)) { __syncthreads(); if (EN(10)) phase_weights(P, lds); } }
            else if (k == 1 && EN(1)) {
                pg8::Gemm g{(const bf16_t*)(P.ws + WS_HN), (const bf16_t*)(P.ws + WS_WIN + l * WIN_L), MT, NPROJ, DM, P.pad, P.rep == 2}; pg8::StaticOrder S; S.init(MT, NPROJ, DM, gdim, bidx);
                pg8::EpiProj E{(bf16_t*)(P.ws + WS_PROJ), NPROJ, P.rep == 3};
                pg8::gemm_phase<pg8::EpiProj, pg8::StaticOrder, false>(lds, g, S, E, nullptr);
            } else if (k == 2 && EN(2)) {
#ifndef PROBE_SUB
#define PROBE_SUB -1
#endif
#define SUBEN(x) (!P.rep || PROBE_SUB < 0 || PROBE_SUB == (x))
#pragma unroll 1
                for (int slot = 0; slot < 4; ++slot) {
                    const int kind = (slot + (bidx >> 3) + (bidx & 7)) & 3;
                    if (kind == 0) {
#pragma unroll 1
                        for (int u = blockIdx.x; u < 512; u += gridDim.x) { if (ENU(0) && SUBEN(0)) ssd_prep_unit(P, lds, l, u >> 1, u & 1); }
                    } else if (kind == 1) {
#pragma unroll 1
                        for (int v = blockIdx.x; v < 512; v += gridDim.x) { if (ENU(1) && SUBEN(1)) attn_prompt_unit(P, lds, l, v >> 7, (v >> 1) & 63, v & 1); }
                    } else if (kind == 2) {
#pragma unroll 1
                        for (int v = blockIdx.x; v < 256; v += gridDim.x) { if (ENU(2) && SUBEN(2)) ssd_sample_unit(P, lds, l, v >> 1, v & 1); }
                    } else {
#pragma unroll 1
                        for (int v = blockIdx.x; v < 256; v += gridDim.x) { if (ENU(3) && SUBEN(3)) attn_sample_unit(P, lds, l, v >> 1, v & 1); }
                    }
                }
            } else if (k == 3 && EN(3)) phase_scan(P, l);
            else if (k == 4 && EN(4)) {
#pragma unroll 1
                for (int u = blockIdx.x; u < 512; u += gridDim.x) ssd_out_unit(P, lds, l, u >> 1, u & 1); }
            else if (k == 5 && EN(5)) {
                pg8::Gemm g{(const bf16_t*)(P.ws + WS_YCAT), (const bf16_t*)(P.ws + WS_WOUT + l * WOUT_L), MT, DM, DM, P.pad, P.rep == 2}; pg8::SplitOrder S; S.init(DM, DM, 4, gdim, bidx);
                pg8::EpiResid E{xin, XB1, (float*)(P.ws + WS_XSL), l != 0, 1};
                pg8::gemm_phase<pg8::EpiResid, pg8::SplitOrder, false>(lds, g, S, E, nullptr);
            } else if (k == 6 && EN(6)) phase_norm<false>(P, lds, l, XB1, 1, XS, P.in[I_N2] + l * DM, 4);
            else if (k == 7 && EN(7)) {
                pg8::Gemm g{(const bf16_t*)(P.ws + WS_HN), (const bf16_t*)(P.ws + WS_WUP + l * WUP_L), MT, NUP, DM, P.pad, P.rep == 2}; pg8::SplitOrder S; S.init(NUP, DM, 4, gdim, bidx);
                pg8::EpiUp E{(bf16_t*)(P.ws + WS_G), (bf16_t*)(P.ws + WS_UH), P.in[I_FCW] + (size_t)l * 3 * NUP, P.in[I_FCB] + (size_t)l * NUP, (float*)(P.ws + WS_US), P.rep >= 3 ? P.rep - 2 : 0};
                pg8::gemm_phase<pg8::EpiUp, pg8::SplitOrder, false>(lds, g, S, E, nullptr);
            } else if (k == 8 && EN(8)) phase_fixup(P, l);
            else if (k == 9 && EN(9)) {
                pg8::Gemm g{(const bf16_t*)(P.ws + WS_G), (const bf16_t*)(P.ws + WS_WDN + l * WDN_L), MT, DM, DFF, P.pad, P.rep == 2}; pg8::SplitOrder S; S.init(DM, DFF, 11, gdim, bidx);
                pg8::EpiResid E{XB1, l == 0 ? XB2 : (void*)X, (float*)(P.ws + WS_XSL), 1, l == 0};
                pg8::gemm_phase<pg8::EpiResid, pg8::SplitOrder, false>(lds, g, S, E, nullptr);
            }
        }
        if (ph + 1 < P.ph_hi && ph != 0) { if (P.ph_hi > 1000) grid.sync(); xcd_barrier(bar, opaque_tid(P.pad) == 0); }
    }
}

extern "C" void kernel_launch(void* const* d_in, const int* in_sizes, int n_in, void* d_out, int out_size, void* d_ws, size_t ws_size, hipStream_t stream) {
    static int grid = 0;
    if (grid == 0) {
        if (n_in != 24 || ws_size < WS_END) { fprintf(stderr, "kernel_launch: unexpected inputs (n_in %d, ws %zu)\n", n_in, ws_size); grid = -1; return; }
        int dev = 0, cus = 0, per_cu = 0;
        hipGetDevice(&dev); hipDeviceGetAttribute(&cus, hipDeviceAttributeMultiprocessorCount, dev);
        hipFuncSetAttribute((const void*)fwd_megakernel, hipFuncAttributeMaxDynamicSharedMemorySize, LDS_BYTES);
        hipOccupancyMaxActiveBlocksPerMultiprocessor(&per_cu, (const void*)fwd_megakernel, 512, LDS_BYTES);
        (void)hipGetLastError();
        if (per_cu < 1) fprintf(stderr, "kernel_launch: occupancy query says %d blocks/CU\n", per_cu);
        grid = cus > 0 ? cus : 256;
    }
    if (grid < 0) return;
    Params p{};
    for (int i = 0; i < 24; ++i) p.in[i] = (const float*)d_in[i];
    p.out = (float*)d_out; p.ws = (unsigned char*)d_ws;
#if MK_MULTI
    for (int ph = 0; ph < N_PHASES; ++ph) { p.ph_lo = ph; p.ph_hi = ph + 1; p.rep = 0; hipLaunchKernelGGL(fwd_megakernel, dim3(grid), dim3(512), LDS_BYTES, stream, p);
#ifdef PROBE_MASK
#ifndef PROBE_REP
#define PROBE_REP 1
#endif
        if (ph <= 10 && ph != 7 && ((PROBE_MASK >> ph) & 1)) { p.rep = PROBE_REP; for (int r = 0; r < 2; ++r) hipLaunchKernelGGL(fwd_megakernel, dim3(grid), dim3(512), LDS_BYTES, stream, p); }
#endif
    }
#else
    p.ph_lo = 0; p.ph_hi = N_PHASES;
    (void)hipMemsetAsync((char*)d_ws + WS_CTL, 0, 65536, stream);
    void* args[] = {&p};
    hipError_t e = hipLaunchCooperativeKernel((const void*)fwd_megakernel, dim3(grid), dim3(512), args, LDS_BYTES, stream);
    if (e != hipSuccess) fprintf(stderr, "cooperative launch failed: %s (grid %d)\n", hipGetErrorString(e), grid);
#endif
}
```

```cpp
#include <hip/hip_runtime.h>
#include <hip/hip_cooperative_groups.h>
#include <cstdio>
#include <cstdint>
namespace cg = cooperative_groups;

#define LAS __attribute__((address_space(3)))
typedef unsigned short bf16_t;
typedef short bf16x8 __attribute__((ext_vector_type(8)));
typedef short bf16x4 __attribute__((ext_vector_type(4)));
typedef float f32x4 __attribute__((ext_vector_type(4)));
typedef float f32x2 __attribute__((ext_vector_type(2)));
typedef unsigned u32x4 __attribute__((ext_vector_type(4)));
typedef unsigned u32x2 __attribute__((ext_vector_type(2)));

#ifndef MK_MULTI
#define MK_MULTI 0
#endif

constexpr int MP = 32768, MS = 512, MT = MP + MS;
constexpr int DM = 1024, NPROJ = 2304, DFF = 2816, NUP = 5632, IN_DIM = 2312;
constexpr int PC_Z = 0, PC_XBC = 512, PC_Q = 1536, PC_K = 2048, PC_V = 2176;
constexpr float EPS = 1e-6f;
constexpr size_t O_Y = 0, O_PSSM = 34078720, O_PCONV = 34603008, O_PK = 34627584, O_PV = 34758656, O_PFFN = 34889728,
                 O_SSSM = 34979840, O_SCONV = 51757056, O_SK = 52543488, O_SV = 56737792, O_SFFN = 60932096;
constexpr size_t MiB = 1u << 20;
constexpr size_t WS_CTL = 0, WS_WIN = 1 * MiB, WS_WOUT = 10 * MiB, WS_WUP = 14 * MiB, WS_WDN = 36 * MiB, WS_HN = 47 * MiB,
                 WS_DT = 112 * MiB, WS_AC = 112 * MiB + 1310720, WS_CD = 112 * MiB + 2621440, WS_XS = 115 * MiB  , WS_XB = 394 * MiB  , WS_YCAT = 117 * MiB, WS_PROJ = 182 * MiB,
                 WS_XTG = 329 * MiB, WS_BCN = 361 * MiB, WS_ST = 394 * MiB, WS_G = 182 * MiB, WS_UH = 361 * MiB, WS_PSTB = 458 * MiB, WS_US = 117 * MiB  , WS_XSL = 458 * MiB  , WS_END = 490 * MiB;
constexpr size_t WIN_L = (size_t)NPROJ * DM * 2, WOUT_L = (size_t)DM * DM * 2, WUP_L = (size_t)NUP * DM * 2, WDN_L = (size_t)DM * DFF * 2;
constexpr int LDS_BYTES = 155648;

__device__ __forceinline__ float bf2f(unsigned b) { return __uint_as_float(b << 16); }
__device__ __forceinline__ unsigned pk2(float lo, float hi) { unsigned r; asm volatile("v_cvt_pk_bf16_f32 %0, %1, %2" : "=v"(r) : "v"(lo), "v"(hi)); return r; }
__device__ __forceinline__ float silu_f(float x) { return x * __builtin_amdgcn_rcpf(1.f + __expf(-x)); }

template <int CTRL> __device__ __forceinline__ float dpp0(float x) {
    return __builtin_bit_cast(float, __builtin_amdgcn_update_dpp(0, __builtin_bit_cast(int, x), CTRL, 0xf, 0xf, true));
}
#define DPP_SHR1 0x111
#define DPP_SHR2 0x112
#define DPP_SHL14 0x10E
#define DPP_SHL15 0x10F
__device__ __forceinline__ bf16x8 cvt8(const f32x4 a, const f32x4 b) {
    u32x4 w; w.x = pk2(a[0], a[1]); w.y = pk2(a[2], a[3]); w.z = pk2(b[0], b[1]); w.w = pk2(b[2], b[3]);
    return __builtin_bit_cast(bf16x8, w);
}
__device__ __forceinline__ int lane_now() { int l; asm volatile("v_mbcnt_lo_u32_b32 %0, -1, 0\n\tv_mbcnt_hi_u32_b32 %0, -1, %0" : "=v"(l)); return l; }
__device__ __forceinline__ int opaque_tid(int wbase) { return wbase + lane_now(); }
__device__ __forceinline__ float shx(float v, int o, int lane) { return __builtin_bit_cast(float, __builtin_amdgcn_ds_bpermute((lane ^ o) << 2, __builtin_bit_cast(int, v))); }
__device__ __forceinline__ float shi(float v, int idx) { return __builtin_bit_cast(float, __builtin_amdgcn_ds_bpermute(idx << 2, __builtin_bit_cast(int, v))); }
__device__ __forceinline__ void gatomic_add(float* p, float v) { (void)__builtin_amdgcn_global_atomic_fadd_f32((__attribute__((address_space(1))) float*)p, v); }
__device__ __forceinline__ float wave_sum(float v, int lane) {
#pragma unroll
    for (int o = 1; o < 64; o <<= 1) v += shx(v, o, lane);
    return v;
}
__device__ __forceinline__ float wave_sum2(float v, int lane) {
    v += dpp0<0xB1>(v); v += dpp0<0x4E>(v); v += dpp0<0x141>(v); v += dpp0<0x140>(v);
    v += shx(v, 16, lane); v += shx(v, 32, lane);
    return v;
}
namespace pg8 {
#define PG8_LAS __attribute__((address_space(3)))
typedef unsigned short bf16_t;
typedef short bf16x8 __attribute__((ext_vector_type(8)));
typedef float f32x4 __attribute__((ext_vector_type(4)));
typedef unsigned u32x4 __attribute__((ext_vector_type(4)));
constexpr int BM = 256, BK = 64, HALF = 128, HTB = HALF * BK * 2  , STAGE_BYTES = 8 * HTB, NXCD = 8, WGM = 8;

__host__ __device__ __forceinline__ int lds_byte(int r, int c) { const int st = (r >> 4) * 2 + (c >> 5), rr = r & 15, cc = c & 31, ob = rr * 64 + cc * 2; return st * 1024 + (ob ^ (((ob >> 9) & 1) << 5)); }
__host__ __device__ __forceinline__ void stage_rc(int b, int& R, int& C) { const int st = b / 1024, sb = b % 1024, swz = sb ^ (((sb >> 9) & 1) << 5); R = (st >> 1) * 16 + swz / 64; C = (st & 1) * 32 + (swz % 64) / 2; }
__host__ __device__ __forceinline__ int perm32(int rho) { const int n = rho >> 4, i = rho & 15; return 8 * (i >> 2) + 4 * n + (i & 3); }

struct Unit { int pm, pn, k0, nt; };
struct Gemm { const bf16_t* A; const bf16_t* Bt; int M, N, K, wbase, skip; };

struct StaticOrder {
    int nM, nN, nwg, G, c, ntk;
    __host__ __device__ void init(int M, int N, int K, int G_, int c_) { nM = M / BM; nN = N / BM; nwg = nM * nN; G = G_; c = c_; ntk = K / BK; }
    __host__ __device__ bool next(int i, Unit& u) const {
        const long L = (long)i * G + c; if (L >= nwg) return false;
        int wgid = (int)L; { const int q = nwg / NXCD, r = nwg % NXCD, xcd = wgid % NXCD, off = wgid / NXCD; wgid = (xcd < r ? xcd * (q + 1) : r * (q + 1) + (xcd - r) * q) + off; }
        const int nig = WGM * nN, gid = wgid / nig, fm = gid * WGM, gsz = (nM - fm) < WGM ? (nM - fm) : WGM;
        u.pm = fm + ((wgid % nig) % gsz); u.pn = (wgid % nig) / gsz; u.k0 = 0; u.nt = ntk; return true;
    }
    __device__ __forceinline__ void a_ready(const Unit&) const {}
    __device__ __forceinline__ void done(const Unit&) const {}
};

struct SplitOrder {
    int nN, nP, nwg, G, c, nsplit, ntk;
    __host__ __device__ void init(int N, int K, int nsplit_, int G_, int c_) { nN = N / BM; nP = 128 * nN; nsplit = nsplit_; nwg = nP + 2 * nN * nsplit; G = G_; c = c_; ntk = K / BK; }
    __host__ __device__ bool next(int i, Unit& u) const {
        const int L = i * G + c; if (L >= nwg) return false;
        const bool pr = L < nP;
        const int wl = pr ? L : 0, wgid = (wl % NXCD) * (nP / NXCD) + wl / NXCD;
        const int nig = WGM * nN, gid = wgid / nig, rem = wgid % nig;
        const int s = pr ? 0 : L - nP, s2 = s >> 1, ks = s2 / nN, nts = ntk / nsplit;
        const int pm = pr ? gid * WGM + rem % WGM : 128 + (s & 1);
        const int pn = pr ? rem / WGM : s2 % nN;
        const int k0 = pr ? 0 : ks * nts * BK;
        const int nt = pr ? ntk : nts;
        u.pm = pm; u.pn = pn; u.k0 = k0; u.nt = nt;
        return true;
    }
    __device__ __forceinline__ void a_ready(const Unit&) const {}
    __device__ __forceinline__ void done(const Unit&) const {}
};
struct EpiProj {
    static constexpr bool PERM = true, AFTER_DRAIN = false;
    bf16_t* O; int ldc; int half;
    __device__ __forceinline__ void operator()(const f32x4 (&acc)[2][2][4][2], const Unit& u, int wr, int wc, int fr, int fq) const {
        { const int ln = lane_now(); fr = ln & 15; fq = ln >> 4; }
        const int row0 = u.pm * BM + wr * 64 + fr, col0 = u.pn * BM + wc * 32 + 8 * fq;
#pragma unroll
        for (int ai = 0; ai < 2; ++ai)
#pragma unroll
            for (int m = 0; m < 4; ++m) { if (half && ai == 1) continue; bf16_t* rowp = O + (size_t)(row0 + ai * HALF + m * 16) * ldc + col0;
#pragma unroll
                for (int bj = 0; bj < 2; ++bj) { const f32x4 v0 = acc[ai][bj][m][0], v1 = acc[ai][bj][m][1];
                    u32x4 w; w.x = pk2(v0[0], v0[1]); w.y = pk2(v0[2], v0[3]); w.z = pk2(v1[0], v1[1]); w.w = pk2(v1[2], v1[3]);
                    *(u32x4*)(rowp + bj * HALF) = w; } }
    }
};
struct EpiResid {
    static constexpr bool PERM = true, AFTER_DRAIN = false;
    const void* res; void* out; float* slab; int res_bf16, out_bf16;
    __device__ __forceinline__ void operator()(const f32x4 (&acc)[2][2][4][2], const Unit& u, int wr, int wc, int fr, int fq) const {
        { const int ln = lane_now(); fr = ln & 15; fq = ln >> 4; }
        const int row0 = u.pm * BM + wr * 64 + fr, col0 = u.pn * BM + wc * 32 + 8 * fq;
#pragma unroll
        for (int ai = 0; ai < 2; ++ai)
#pragma unroll
            for (int m = 0; m < 4; ++m) { const int row = row0 + ai * HALF + m * 16;
                if (u.pm >= 128) {
                    float* sp = slab + ((size_t)(u.k0 / (u.nt * BK)) * MS + (row - MP)) * DM + col0;
#pragma unroll
                    for (int bj = 0; bj < 2; ++bj)
#pragma unroll
                        for (int n = 0; n < 2; ++n) *(f32x4*)(sp + bj * HALF + 4 * n) = acc[ai][bj][m][n];
                } else {
                    f32x4 rv[2][2];
                    if (res_bf16) { const bf16_t* rp = (const bf16_t*)res + (size_t)row * DM + col0;
#pragma unroll
                        for (int bj = 0; bj < 2; ++bj) { const u32x4 t = *(const u32x4*)(rp + bj * HALF);
                            rv[bj][0] = (f32x4){bf2f(t.x & 0xffffu), bf2f(t.x >> 16), bf2f(t.y & 0xffffu), bf2f(t.y >> 16)}; rv[bj][1] = (f32x4){bf2f(t.z & 0xffffu), bf2f(t.z >> 16), bf2f(t.w & 0xffffu), bf2f(t.w >> 16)}; }
                    } else { const float* rp = (const float*)res + (size_t)row * DM + col0;
#pragma unroll
                        for (int bj = 0; bj < 2; ++bj)
#pragma unroll
                            for (int n = 0; n < 2; ++n) rv[bj][n] = *(const f32x4*)(rp + bj * HALF + 4 * n);
                    }
                    if (out_bf16) { bf16_t* op = (bf16_t*)out + (size_t)row * DM + col0;
#pragma unroll
                        for (int bj = 0; bj < 2; ++bj) { const f32x4 v0 = rv[bj][0] + acc[ai][bj][m][0], v1 = rv[bj][1] + acc[ai][bj][m][1];
                            u32x4 w; w.x = pk2(v0[0], v0[1]); w.y = pk2(v0[2], v0[3]); w.z = pk2(v1[0], v1[1]); w.w = pk2(v1[2], v1[3]); *(u32x4*)(op + bj * HALF) = w; }
                    } else { float* op = (float*)out + (size_t)row * DM + col0;
#pragma unroll
                        for (int bj = 0; bj < 2; ++bj)
#pragma unroll
                            for (int n = 0; n < 2; ++n) *(f32x4*)(op + bj * HALF + 4 * n) = rv[bj][n] + acc[ai][bj][m][n];
                    }
                } }
    }
};
struct EpiUp {
    static constexpr bool PERM = true, AFTER_DRAIN = false;
    bf16_t* G; bf16_t* UH; const float* cw; const float* cb; float* US; int nost;
    __device__ __forceinline__ void operator()(const f32x4 (&acc)[2][2][4][2], const Unit& u, int wr, int wc, int fr, int fq) const {
        { const int ln = lane_now(); fr = ln & 15; fq = ln >> 4; }
        const int jbase = u.pn * 128 + wc * 32 + 8 * fq;
        if (u.pm >= 128) {
            float* sb = US + (size_t)(u.k0 / (u.nt * BK)) * MS * NUP;
#pragma unroll
            for (int ai = 0; ai < 2; ++ai)
#pragma unroll
                for (int m = 0; m < 4; ++m) { __builtin_amdgcn_sched_barrier(0); float* up = sb + (size_t)(u.pm * BM + ai * HALF + wr * 64 + 16 * m + fr - MP) * NUP + jbase;
#pragma unroll
                    for (int n = 0; n < 2; ++n) { *(f32x4*)(up + 4 * n) = acc[ai][0][m][n]; *(f32x4*)(up + DFF + 4 * n) = acc[ai][1][m][n]; } }
            return;
        }
        f32x4 prm[2][8];
#pragma unroll
        for (int n = 0; n < 2; ++n) { const int j = jbase + 4 * n;
            prm[n][0] = *(const f32x4*)(cw + j); prm[n][1] = *(const f32x4*)(cw + NUP + j); prm[n][2] = *(const f32x4*)(cw + 2 * NUP + j); prm[n][3] = *(const f32x4*)(cb + j);
            prm[n][4] = *(const f32x4*)(cw + DFF + j); prm[n][5] = *(const f32x4*)(cw + NUP + DFF + j); prm[n][6] = *(const f32x4*)(cw + 2 * NUP + DFF + j); prm[n][7] = *(const f32x4*)(cb + DFF + j); }
#pragma unroll
        for (int ai = 0; ai < 2; ++ai) {
            const int rowg = u.pm * BM + ai * HALF + wr * 64;
#pragma unroll
            for (int m = 0; m < 4; ++m) {
                __builtin_amdgcn_sched_barrier(0);
                const int r = rowg + 16 * m + fr;
                unsigned pk[4];
#pragma unroll
                for (int n = 0; n < 2; ++n) {
                    const f32x4 w0g = prm[n][0], w1g = prm[n][1], w2g = prm[n][2], bg = prm[n][3], w0v = prm[n][4], w1v = prm[n][5], w2v = prm[n][6], bv = prm[n][7];
                    const f32x4 vg = acc[ai][0][m][n], vv = acc[ai][1][m][n];
                    const f32x4 tg = w1g * vg, sg = w0g * vg, tv = w1v * vv, sv = w0v * vv;
                    f32x4 cg_ = w2g * vg + bg, cv_ = w2v * vv + bv;
#pragma unroll
                    for (int i = 0; i < 4; ++i) {
                        cg_[i] += dpp0<DPP_SHR1>(tg[i] + dpp0<DPP_SHR1>(sg[i]));
                        cv_[i] += dpp0<DPP_SHR1>(tv[i] + dpp0<DPP_SHR1>(sv[i]));
                        if (m > 0) { const float og = acc[ai][0][m > 0 ? m - 1 : 0][n][i], ov = acc[ai][1][m > 0 ? m - 1 : 0][n][i];
                            cg_[i] += dpp0<DPP_SHL15>(w1g[i] * og) + dpp0<DPP_SHL14>(w0g[i] * og); cv_[i] += dpp0<DPP_SHL15>(w1v[i] * ov) + dpp0<DPP_SHL14>(w0v[i] * ov); }
                    }
                    pk[2 * n] = pk2(silu_f(cg_[0]) * cv_[0], silu_f(cg_[1]) * cv_[1]); pk[2 * n + 1] = pk2(silu_f(cg_[2]) * cv_[2], silu_f(cg_[3]) * cv_[3]);
                }
                int slot = -1;
                if (m == 0 && fr < 2) slot = fr; else if (m == 3 && fr >= 14) slot = fr - 12;
                if (slot >= 0 && !(nost & 2)) { bf16_t* up = UH + ((size_t)(r >> 6) * 4 + slot) * NUP + jbase;
                    const f32x4 g0 = acc[ai][0][m][0], g1 = acc[ai][0][m][1], v0 = acc[ai][1][m][0], v1 = acc[ai][1][m][1];
                    u32x4 a, b2; a.x = pk2(g0[0], g0[1]); a.y = pk2(g0[2], g0[3]); a.z = pk2(g1[0], g1[1]); a.w = pk2(g1[2], g1[3]);
                    b2.x = pk2(v0[0], v0[1]); b2.y = pk2(v0[2], v0[3]); b2.z = pk2(v1[0], v1[1]); b2.w = pk2(v1[2], v1[3]);
                    *(u32x4*)up = a; *(u32x4*)(up + DFF) = b2; }
                if (!(m == 0 && fr < 2) && !(nost & 1)) { u32x4 w; w.x = pk[0]; w.y = pk[1]; w.z = pk[2]; w.w = pk[3]; *(u32x4*)(G + (size_t)r * DFF + jbase) = w; }
            }
        }
    }
};
template <class Epi, class Sched, bool STAMP = false>
__device__ __forceinline__ void gemm_phase(PG8_LAS unsigned char* lds, const Gemm g, const Sched& S, const Epi& E, unsigned long long* stamps) {
    const int tid = opaque_tid(g.wbase), wid = __builtin_amdgcn_readfirstlane(tid >> 6), lane = tid & 63, wr = wid >> 2, wc = wid & 3, fr = lane & 15, fq = lane >> 4;
    const int K = g.K;
    int ts_lo = 0, ts_hi = 0, nts = 0; const unsigned long long rt_entry = STAMP ? (unsigned long long)wall_clock64() : 0ull;
#define PG8_STAMP() do { if (STAMP && wid == 0 && nts < 64) { const unsigned long long _c = (unsigned long long)clock64(); \
        ts_lo = (lane == nts) ? (int)(unsigned)_c : ts_lo; ts_hi = (lane == nts) ? (int)(unsigned)(_c >> 32) : ts_hi; ++nts; } } while (0)
    PG8_STAMP();
    unsigned voffA[2], voffB[2];
#pragma unroll
    for (int i = 0; i < 2; ++i) { int R, C; stage_rc(tid * 16 + i * 8192, R, C); const int Rb = Epi::PERM ? ((R & ~31) + perm32(R & 31)) : R;
        voffA[i] = (unsigned)(R * K + C) * 2u; voffB[i] = (unsigned)(Rb * K + C) * 2u; }
    const size_t kstep = (size_t)(BK * 2);
    const size_t hstep = (size_t)HALF * K * 2;
    const size_t tstep = 2 * hstep;
    const unsigned ldsw = (unsigned)wid * 1024u;
    const int aoff = lds_byte(wr * 64 + fr, fq * 8), boff = lds_byte(wc * 32 + fr, fq * 8);
#define PG8_SA(b, h) (((b) * 2 + (h)) * HTB)
#define PG8_SB(b, h) ((4 + (b) * 2 + (h)) * HTB)
#define PG8_STAGE(bufoff, gbase, voff) do { _Pragma("unroll") for (int _i = 0; _i < 2; ++_i) \
        __builtin_amdgcn_global_load_lds((const unsigned*)((const char*)(gbase) + (voff)[_i]), (PG8_LAS unsigned*)(lds + (bufoff) + ldsw + _i * 8192), 16, 0, 0); } while (0)
#define PG8_LDA(dst, b, h) do { _Pragma("unroll") for (int m = 0; m < 4; ++m) _Pragma("unroll") for (int k = 0; k < 2; ++k) dst[m][k] = *(const PG8_LAS bf16x8*)(lds + PG8_SA(b, h) + aoff + m * 2048 + k * 1024); } while (0)
#define PG8_LDB(dst, b, h) do { _Pragma("unroll") for (int n = 0; n < 2; ++n) _Pragma("unroll") for (int k = 0; k < 2; ++k) dst[n][k] = *(const PG8_LAS bf16x8*)(lds + PG8_SB(b, h) + boff + n * 2048 + k * 1024); } while (0)
#define PG8_MMA(ai, bj, At, Bt) do { __builtin_amdgcn_s_setprio(1); _Pragma("unroll") for (int m = 0; m < 4; ++m) _Pragma("unroll") for (int n = 0; n < 2; ++n) _Pragma("unroll") for (int k = 0; k < 2; ++k) \
        acc[ai][bj][m][n] = __builtin_amdgcn_mfma_f32_16x16x32_bf16(Bt[n][k], At[m][k], acc[ai][bj][m][n], 0, 0, 0); __builtin_amdgcn_s_setprio(0); } while (0)
#define PG8_WAIT_V(n) asm volatile("s_waitcnt vmcnt(" #n ")" ::: "memory")
#define PG8_WAIT_L(n) asm volatile("s_waitcnt lgkmcnt(" #n ")" ::: "memory")
#define PG8_BAR __builtin_amdgcn_s_barrier()
#define PG8_SCHED __builtin_amdgcn_sched_barrier(0)
    Unit cur, nxt; int ui = 0;
    if (!S.next(0, cur)) return;
    f32x4 acc[2][2][4][2];
#pragma unroll
    for (int a = 0; a < 2; ++a)
#pragma unroll
        for (int b = 0; b < 2; ++b)
#pragma unroll
            for (int m = 0; m < 4; ++m)
#pragma unroll
                for (int n = 0; n < 2; ++n) acc[a][b][m][n] = (f32x4){0.f, 0.f, 0.f, 0.f};
    bf16x8 At[4][2], B0[2][2], B1[2][2];
    const char* cA = (const char*)g.A + (size_t)cur.pm * tstep + (size_t)cur.k0 * 2; const char* cB = (const char*)g.Bt + (size_t)cur.pn * tstep + (size_t)cur.k0 * 2;
    S.a_ready(cur);
    PG8_STAGE(PG8_SB(0, 0), cB, voffB); PG8_STAGE(PG8_SB(0, 1), cB + hstep, voffB); PG8_STAGE(PG8_SA(0, 0), cA, voffA); PG8_STAGE(PG8_SA(0, 1), cA + hstep, voffA);
    if (wr == 1) PG8_BAR;
    PG8_WAIT_V(2); PG8_BAR;
    PG8_STAGE(PG8_SB(1, 0), cB + kstep, voffB); PG8_STAGE(PG8_SA(1, 0), cA + kstep, voffA); PG8_STAGE(PG8_SB(1, 1), cB + hstep + kstep, voffB);
    PG8_WAIT_V(6); PG8_BAR;
    PG8_STAMP();
    for (;;) {
        const bool has_next = S.next(ui + 1, nxt);
        const char* nA = has_next ? (const char*)g.A + (size_t)nxt.pm * tstep + (size_t)nxt.k0 * 2 : cA; const char* nB = has_next ? (const char*)g.Bt + (size_t)nxt.pn * tstep + (size_t)nxt.k0 * 2 : cB;
        const int nt = cur.nt;
        for (int t = 0; t < nt; t += 2) {
            const bool last = (t == nt - 2);
            const char* a1 = cA + (size_t)(t + 1) * kstep;
            const char* a2 = last ? nA : cA + (size_t)(t + 2) * kstep; const char* b2 = last ? nB : cB + (size_t)(t + 2) * kstep;
            const char* a3 = a2 + kstep; const char* b3 = b2 + kstep;
            if (last && has_next) S.a_ready(nxt);
            PG8_LDB(B0, 0, 0); PG8_LDB(B1, 0, 1); PG8_SCHED; PG8_LDA(At, 0, 0); PG8_STAGE(PG8_SA(1, 1), a1 + hstep, voffA);
            PG8_WAIT_V(8); PG8_WAIT_L(0); PG8_BAR; PG8_MMA(0, 0, At, B0); PG8_MMA(0, 1, At, B1); PG8_BAR; PG8_SCHED;
            PG8_LDA(At, 0, 1); PG8_STAGE(PG8_SB(0, 0), b2, voffB); PG8_STAGE(PG8_SB(0, 1), b2 + hstep, voffB); PG8_STAGE(PG8_SA(0, 0), a2, voffA);
            PG8_WAIT_V(8); PG8_WAIT_L(0); PG8_BAR; PG8_MMA(1, 0, At, B0); PG8_MMA(1, 1, At, B1); PG8_BAR; PG8_SCHED;
            PG8_LDB(B0, 1, 0); PG8_LDB(B1, 1, 1); PG8_SCHED; PG8_LDA(At, 1, 0); PG8_STAGE(PG8_SA(0, 1), a2 + hstep, voffA);
            PG8_WAIT_V(8); PG8_WAIT_L(0); PG8_BAR; PG8_MMA(0, 0, At, B0); PG8_MMA(0, 1, At, B1); PG8_BAR; PG8_SCHED;
            PG8_LDA(At, 1, 1); PG8_STAGE(PG8_SB(1, 0), b3, voffB); PG8_STAGE(PG8_SB(1, 1), b3 + hstep, voffB); PG8_STAGE(PG8_SA(1, 0), a3, voffA);
            PG8_WAIT_V(8); PG8_WAIT_L(0); PG8_BAR; PG8_MMA(1, 0, At, B0); PG8_MMA(1, 1, At, B1); PG8_BAR; PG8_SCHED;
        }
        PG8_STAMP();
        if (wr == 0) PG8_BAR;
        if constexpr (!Epi::AFTER_DRAIN) { if (!g.skip) E(acc, cur, wr, wc, fr, fq); S.done(cur); }
        PG8_STAMP();
        if (!has_next) break;
#pragma unroll
        for (int a = 0; a < 2; ++a)
#pragma unroll
            for (int b = 0; b < 2; ++b)
#pragma unroll
                for (int m = 0; m < 4; ++m)
#pragma unroll
                    for (int n = 0; n < 2; ++n) acc[a][b][m][n] = (f32x4){0.f, 0.f, 0.f, 0.f};
        cur = nxt; cA = nA; cB = nB; ++ui;
        if (wr == 1) PG8_BAR;
    }
    PG8_WAIT_V(0);
    PG8_BAR;
    if constexpr (Epi::AFTER_DRAIN) { E.fused(acc, cur, wr, wc, fr, fq, lds, wid, lane); S.done(cur); }
    PG8_STAMP();
    if (STAMP && wid == 0) { stamps[lane] = lane < nts ? (((unsigned long long)(unsigned)ts_hi << 32) | (unsigned)ts_lo) : 0ull;
        if (lane == 62) stamps[62] = rt_entry; if (lane == 63) stamps[63] = (unsigned long long)wall_clock64(); }
#undef PG8_STAMP
#undef PG8_SA
#undef PG8_SB
#undef PG8_STAGE
#undef PG8_LDA
#undef PG8_LDB
#undef PG8_MMA
#undef PG8_WAIT_V
#undef PG8_WAIT_L
#undef PG8_BAR
#undef PG8_SCHED
}
}

struct Params { const float* in[24]; float* out; unsigned char* ws; int ph_lo, ph_hi, rep, pad; };
enum { I_XP = 0, I_XS, I_SSM, I_SCONV, I_CK, I_CV, I_SFFN, I_N1, I_WIN, I_CW, I_CB, I_DTB, I_ALOG, I_DSKIP, I_SNORM, I_QN, I_KN, I_SINK, I_WOUT, I_N2, I_WUP, I_FCW, I_FCB, I_WDN };

__device__ __forceinline__ void transpose_item(const float* W, int K, int N, int srccol0, bf16_t* WT, int dstrow0, int k0, LAS float* scr, int lane) {
    float tmp[32];
#pragma unroll
    for (int i = 0; i < 32; ++i) tmp[i] = W[(size_t)(k0 + 2 * i + (lane >> 5)) * N + srccol0 + (lane & 31)];
#pragma unroll
    for (int i = 0; i < 32; ++i) scr[(2 * i + (lane >> 5)) * 33 + (lane & 31)] = tmp[i];
    asm volatile("s_waitcnt lgkmcnt(0)" ::: "memory");
    const int c = lane & 7;
#pragma unroll
    for (int j = 0; j < 4; ++j) { const int n = (lane >> 3) + 8 * j; const LAS float* s = scr + (8 * c) * 33 + n;
        u32x4 o; o.x = pk2(s[0 * 33], s[1 * 33]); o.y = pk2(s[2 * 33], s[3 * 33]); o.z = pk2(s[4 * 33], s[5 * 33]); o.w = pk2(s[6 * 33], s[7 * 33]);
        *(u32x4*)(WT + (size_t)(dstrow0 + n) * K + k0 + 8 * c) = o; }
    asm volatile("s_waitcnt lgkmcnt(0)" ::: "memory");
}
__device__ __forceinline__ void phase_weights(const Params& P, LAS unsigned char* lds) {
    const int tid = opaque_tid(P.pad), lane = tid & 63, wave = tid >> 6;
    LAS float* scr = (LAS float*)(lds + wave * 16384);
    const int gw = blockIdx.x * 8 + wave, NGW = gridDim.x * 8;
    constexpr int I_A = 16 * 72, I_B = 16 * 32, I_C = 16 * 176, I_D = 44 * 32, PER = I_A + I_B + I_C + I_D;
    for (int it = gw; it < 2 * PER; it += NGW) {
        const int l = it / PER; int r = it % PER;
        if (r < I_A) { const int kb = r / 72, nb = r % 72, n0 = 32 * nb;
            transpose_item(P.in[I_WIN] + (size_t)l * DM * IN_DIM, DM, IN_DIM, n0 + (n0 >= 1536 ? 8 : 0), (bf16_t*)(P.ws + WS_WIN + l * WIN_L), n0, 64 * kb, scr, lane); continue; }
        r -= I_A;
        if (r < I_B) { const int kb = r / 32, nb = r % 32;
            transpose_item(P.in[I_WOUT] + (size_t)l * DM * DM, DM, DM, 32 * nb, (bf16_t*)(P.ws + WS_WOUT + l * WOUT_L), 32 * nb, 64 * kb, scr, lane); continue; }
        r -= I_B;
        if (r < I_C) { const int kb = r / 176, nb = r % 176, n0 = 32 * nb, pn = n0 >> 8, rem = n0 & 255, bj = rem >> 7, cc = rem & 127;
            transpose_item(P.in[I_WUP] + (size_t)l * DM * NUP, DM, NUP, bj * DFF + pn * 128 + cc, (bf16_t*)(P.ws + WS_WUP + l * WUP_L), n0, 64 * kb, scr, lane); continue; }
        r -= I_C;
        { const int kb = r / 32, nb = r % 32;
            transpose_item(P.in[I_WDN] + (size_t)l * DFF * DM, DFF, DM, 32 * nb, (bf16_t*)(P.ws + WS_WDN + l * WDN_L), 32 * nb, 64 * kb, scr, lane); }
    }
}

template <bool WITH_DT>
__device__ __forceinline__ void phase_norm(const Params& P, LAS unsigned char* lds, int l, const void* xP, int xP_bf16, const float* xS, const float* nw, int nslab) {
    const int tid = opaque_tid(P.pad), lane = tid & 63, wave = tid >> 6;
    bf16_t* HN = (bf16_t*)(P.ws + WS_HN);
    LAS float* WD = (LAS float*)lds;
    if (WITH_DT) {
        const float* win = P.in[I_WIN] + (size_t)l * DM * IN_DIM + 1536;
        for (int e = tid; e < DM * 8; e += 512) WD[(e & 7) * DM + (e >> 3)] = win[(size_t)(e >> 3) * IN_DIM + (e & 7)];
        __syncthreads();
    }
    f32x4 wv[4];
#pragma unroll
    for (int j = 0; j < 2; ++j) { wv[2 * j] = *(const f32x4*)(nw + 8 * lane + 512 * j); wv[2 * j + 1] = *(const f32x4*)(nw + 8 * lane + 512 * j + 4); }
    const int gw = blockIdx.x * 8 + wave, NGW = gridDim.x * 8;
    u32x4 nx[4];
#define NORM_LOAD(dst, r) do { if ((r) < MP && xP_bf16) { const bf16_t* xr_ = (const bf16_t*)xP + (size_t)(r) * DM + 8 * lane; dst[0] = *(const u32x4*)xr_; dst[1] = *(const u32x4*)(xr_ + 512); } \
        else if ((r) < MT) { const float* xr_ = ((r) < MP) ? (const float*)xP + (size_t)(r) * DM + 8 * lane : xS + (size_t)((r) - MP) * DM + 8 * lane; \
            dst[0] = *(const u32x4*)xr_; dst[1] = *(const u32x4*)(xr_ + 4); dst[2] = *(const u32x4*)(xr_ + 512); dst[3] = *(const u32x4*)(xr_ + 516); } } while (0)
    NORM_LOAD(nx, gw);
    for (int row = gw; row < MT; row += NGW) {
        f32x4 v[4]; float s = 0.f;
        u32x4 cu[4];
#pragma unroll
        for (int j = 0; j < 4; ++j) cu[j] = nx[j];
        { const int rn = row + NGW; NORM_LOAD(nx, rn); }
        if (row < MP && xP_bf16) {
#pragma unroll
            for (int j = 0; j < 2; ++j) { v[2 * j] = (f32x4){bf2f(cu[j].x & 0xffffu), bf2f(cu[j].x >> 16), bf2f(cu[j].y & 0xffffu), bf2f(cu[j].y >> 16)};
                v[2 * j + 1] = (f32x4){bf2f(cu[j].z & 0xffffu), bf2f(cu[j].z >> 16), bf2f(cu[j].w & 0xffffu), bf2f(cu[j].w >> 16)}; }
        } else {
#pragma unroll
            for (int j = 0; j < 4; ++j) v[j] = __builtin_bit_cast(f32x4, cu[j]);
        }
        if (row >= MP) {
            const float* sl = (const float*)(P.ws + WS_XSL) + (size_t)(row - MP) * DM + 8 * lane;
            for (int k = 0; k < nslab; ++k)
#pragma unroll
                for (int j = 0; j < 2; ++j) { v[2 * j] = v[2 * j] + *(const f32x4*)(sl + (size_t)k * MS * DM + 512 * j); v[2 * j + 1] = v[2 * j + 1] + *(const f32x4*)(sl + (size_t)k * MS * DM + 512 * j + 4); }
            float* xo = (float*)(P.ws + WS_XS) + (size_t)(row - MP) * DM + 8 * lane;
#pragma unroll
            for (int j = 0; j < 2; ++j) { *(f32x4*)(xo + 512 * j) = v[2 * j]; *(f32x4*)(xo + 512 * j + 4) = v[2 * j + 1]; }
        }
#pragma unroll
        for (int j = 0; j < 4; ++j) s += (v[j][0] * v[j][0] + v[j][1] * v[j][1]) + (v[j][2] * v[j][2] + v[j][3] * v[j][3]);
        const float rstd = rsqrtf(wave_sum2(s, lane) * (1.f / DM) + EPS);
#pragma unroll
        for (int j = 0; j < 4; ++j) v[j] = v[j] * rstd * wv[j];
#pragma unroll
        for (int j = 0; j < 2; ++j) { u32x4 o; o.x = pk2(v[2 * j][0], v[2 * j][1]); o.y = pk2(v[2 * j][2], v[2 * j][3]); o.z = pk2(v[2 * j + 1][0], v[2 * j + 1][1]); o.w = pk2(v[2 * j + 1][2], v[2 * j + 1][3]);
            *(u32x4*)(HN + (size_t)row * DM + 8 * lane + 512 * j) = o; }
        if (WITH_DT) {
            float d[8];
#pragma unroll
            for (int h = 0; h < 8; ++h) d[h] = 0.f;
#pragma unroll
            for (int h = 0; h < 8; ++h)
#pragma unroll
                for (int j = 0; j < 2; ++j) { const f32x4 a = *(const LAS f32x4*)(WD + h * DM + 8 * lane + 512 * j), b = *(const LAS f32x4*)(WD + h * DM + 8 * lane + 512 * j + 4);
                    d[h] += ((v[2 * j][0] * a[0] + v[2 * j][1] * a[1]) + (v[2 * j][2] * a[2] + v[2 * j][3] * a[3])) + ((v[2 * j + 1][0] * b[0] + v[2 * j + 1][1] * b[1]) + (v[2 * j + 1][2] * b[2] + v[2 * j + 1][3] * b[3])); }
#pragma unroll
            for (int h = 0; h < 8; ++h) d[h] = wave_sum2(d[h], lane);
            if (lane < 8) { float dv = d[0];
#pragma unroll
                for (int h = 1; h < 8; ++h) dv = (lane == h) ? d[h] : dv;
                dv += P.in[I_DTB][l * 8 + lane];
                const float e = __expf(-fabsf(dv));
                const float sp = fmaxf(dv, 0.f) + (e < 0.03f ? e * (1.f - e * (0.5f - e * (0.33333333f - 0.25f * e))) : __logf(1.f + e));
                ((float*)(P.ws + WS_DT))[(size_t)row * 8 + lane] = sp; }
        }
    }
#undef NORM_LOAD
}

__device__ __forceinline__ void attn_tile(const u32x4 a, const u32x4 b, const float* qw, const LAS bf16_t* Ks, const LAS bf16_t* VT, int jj0, int relbase, int kmin, int kmax,
                                          float slope, float sink, bf16_t* out, int r, int q) {
    const int lane = r + 16 * q;
    bf16x8 qf[2];
    {
        float x[16];
#pragma unroll
        for (int i = 0; i < 4; ++i) { x[2 * i] = bf2f(a[i] & 0xffffu); x[2 * i + 1] = bf2f(a[i] >> 16); x[8 + 2 * i] = bf2f(b[i] & 0xffffu); x[8 + 2 * i + 1] = bf2f(b[i] >> 16); }
        float ss = 0.f;
#pragma unroll
        for (int i = 0; i < 16; ++i) ss += x[i] * x[i];
        ss += shx(ss, 16, lane); ss += shx(ss, 32, lane);
        const float sc = rsqrtf(ss * (1.f / 64.f) + EPS) * 0.125f;
        const f32x4 w0 = *(const f32x4*)(qw + 8 * q), w1 = *(const f32x4*)(qw + 8 * q + 4), w2 = *(const f32x4*)(qw + 32 + 8 * q), w3 = *(const f32x4*)(qw + 36 + 8 * q);
        const f32x4 a0 = {x[0] * sc * w0[0], x[1] * sc * w0[1], x[2] * sc * w0[2], x[3] * sc * w0[3]}, a1 = {x[4] * sc * w1[0], x[5] * sc * w1[1], x[6] * sc * w1[2], x[7] * sc * w1[3]};
        const f32x4 b0 = {x[8] * sc * w2[0], x[9] * sc * w2[1], x[10] * sc * w2[2], x[11] * sc * w2[3]}, b1 = {x[12] * sc * w3[0], x[13] * sc * w3[1], x[14] * sc * w3[2], x[15] * sc * w3[3]};
        qf[0] = cvt8(a0, a1); qf[1] = cvt8(b0, b1);
    }
    f32x4 s[9];
#pragma unroll
    for (int kt = 0; kt < 9; ++kt) {
        if (kt == 4) __builtin_amdgcn_sched_barrier(0);
        s[kt] = (f32x4){0.f, 0.f, 0.f, 0.f};
#pragma unroll
        for (int ks = 0; ks < 2; ++ks) { const bf16x8 kf = *(const LAS bf16x8*)(Ks + (jj0 + 16 * kt + r) * 72 + 32 * ks + 8 * q);
            s[kt] = __builtin_amdgcn_mfma_f32_16x16x32_bf16(kf, qf[ks], s[kt], 0, 0, 0); }
    }
    __builtin_amdgcn_sched_barrier(0);
    float mx = sink;
#pragma unroll
    for (int kt = 0; kt < 9; ++kt)
#pragma unroll
        for (int j = 0; j < 4; ++j) { const int kl = 16 * kt + 4 * q + j, rel = relbase - kl; const bool valid = (rel >= 0) && (rel < 128) && (kl >= kmin) && (kl < kmax);
            const float v = valid ? s[kt][j] - slope * (float)rel : -1e30f; s[kt][j] = v; mx = fmaxf(mx, v); }
    mx = fmaxf(mx, shx(mx, 16, lane)); mx = fmaxf(mx, shx(mx, 32, lane));
    float den = 0.f;
#pragma unroll
    for (int kt = 0; kt < 9; ++kt)
#pragma unroll
        for (int j = 0; j < 4; ++j) { const float p = (s[kt][j] > -1e29f) ? __expf(s[kt][j] - mx) : 0.f; s[kt][j] = p; den += p; }
    den += shx(den, 16, lane); den += shx(den, 32, lane);
    den += __expf(sink - mx);
    const float inv = 1.f / den;
    __builtin_amdgcn_sched_barrier(0);
    f32x4 o[4];
#pragma unroll
    for (int dt = 0; dt < 4; ++dt) o[dt] = (f32x4){0.f, 0.f, 0.f, 0.f};
#pragma unroll
    for (int kk = 0; kk < 5; ++kk) {
        if (kk == 2) __builtin_amdgcn_sched_barrier(0);
        const f32x4 z4 = {0.f, 0.f, 0.f, 0.f};
        const bf16x8 pf = cvt8(s[2 * kk], (2 * kk + 1 < 9) ? s[2 * kk + 1 < 9 ? 2 * kk + 1 : 8] : z4);
#pragma unroll
        for (int dt = 0; dt < 4; ++dt) {
            const LAS bf16_t* vp = VT + (16 * dt + r) * 264 + jj0 + 32 * kk + 4 * q;
            const u32x2 lo = *(const LAS u32x2*)vp; u32x2 hi = {0u, 0u};
            if (2 * kk + 1 < 9) hi = *(const LAS u32x2*)(vp + 16);
            u32x4 w; w.x = lo.x; w.y = lo.y; w.z = hi.x; w.w = hi.y;
            o[dt] = __builtin_amdgcn_mfma_f32_16x16x32_bf16(__builtin_bit_cast(bf16x8, w), pf, o[dt], 0, 0, 0);
        }
    }
#pragma unroll
    for (int dt = 0; dt < 4; ++dt) { u32x2 w; w.x = pk2(o[dt][0] * inv, o[dt][1] * inv); w.y = pk2(o[dt][2] * inv, o[dt][3] * inv); *(u32x2*)(out + 16 * dt + 4 * q) = w; }
}

__device__ __forceinline__ void ssd_prep_unit(const Params& P, LAS unsigned char* lds, int l, int ci, int g) {
    const int tid = opaque_tid(P.pad), lane = tid & 63, wave = tid >> 6;
    const bf16_t* PROJ = (const bf16_t*)(P.ws + WS_PROJ);
    const float* DT = (const float*)(P.ws + WS_DT);
    float* AC = (float*)(P.ws + WS_AC); float* CD = (float*)(P.ws + WS_CD);
    bf16_t* XTG = (bf16_t*)(P.ws + WS_XTG); bf16_t* BCN = (bf16_t*)(P.ws + WS_BCN); float* ST = (float*)(P.ws + WS_ST);
    LAS bf16_t* XTs = (LAS bf16_t*)lds;
    LAS bf16_t* BT = (LAS bf16_t*)(lds + 69632);
    LAS float* WG = (LAS float*)(lds + 104448);
    const int r0 = ci * 128, c = ci & 63;
    const int cp = tid & 255, th = tid >> 8, lc = 2 * cp;
    int xc; if (lc < 256) xc = g * 256 + lc; else if (lc < 384) xc = 512 + g * 128 + (lc - 256); else xc = 768 + g * 128 + (lc - 384);
    const int t0 = 64 * th;
    const bf16_t* src = PROJ + (size_t)(r0 + t0) * NPROJ + PC_XBC + xc;
    unsigned raw[64];
#pragma unroll
    for (int i = 0; i < 64; ++i) raw[i] = *(const unsigned*)(src + (size_t)i * NPROJ);
    if (wave < 4) {
        const int h = 4 * g + wave; const float a = -__expf(P.in[I_ALOG][l * 8 + h]);
        const float d0 = DT[(size_t)(r0 + lane) * 8 + h], d1 = DT[(size_t)(r0 + 64 + lane) * 8 + h];
        float v0 = d0 * a, v1 = d1 * a;
#pragma unroll
        for (int o = 1; o < 64; o <<= 1) { const int src = lane >= o ? lane - o : lane; const float t0 = shi(v0, src), t1 = shi(v1, src); if (lane >= o) { v0 += t0; v1 += t1; } }
        const float tot0 = shi(v0, 63); v1 += tot0;
        const float last = shi(v1, 63);
        AC[(size_t)(r0 + lane) * 8 + h] = v0; AC[(size_t)(r0 + 64 + lane) * 8 + h] = v1;
        WG[wave * 128 + lane] = __expf(last - v0) * d0; WG[wave * 128 + 64 + lane] = __expf(last - v1) * d1;
        if (lane == 0) CD[ci * 8 + h] = __expf(last);
    }
    __syncthreads();
    {
        const float* cw = P.in[I_CW] + (size_t)l * 4 * 1024 + xc; const float* cb = P.in[I_CB] + (size_t)l * 1024 + xc;
        const f32x2 w0 = *(const f32x2*)cw, w1 = *(const f32x2*)(cw + 1024), w2 = *(const f32x2*)(cw + 2048), w3 = *(const f32x2*)(cw + 3072), bb = *(const f32x2*)cb;
        f32x2 h0 = {0.f, 0.f}, h1 = {0.f, 0.f}, h2 = {0.f, 0.f};
        if (!(c == 0 && th == 0)) {
            const unsigned a = *(const unsigned*)(src - 3 * NPROJ), b = *(const unsigned*)(src - 2 * NPROJ), d = *(const unsigned*)(src - NPROJ);
            h0 = (f32x2){bf2f(a & 0xffffu), bf2f(a >> 16)}; h1 = (f32x2){bf2f(b & 0xffffu), bf2f(b >> 16)}; h2 = (f32x2){bf2f(d & 0xffffu), bf2f(d >> 16)};
        }
        const int hl = lc >> 6;
#pragma unroll
        for (int tb = 0; tb < 8; ++tb) {
            float o0[8], o1[8];
#pragma unroll
            for (int i = 0; i < 8; ++i) {
                const int t = t0 + 8 * tb + i;
                const unsigned a = raw[8 * tb + i];
                const f32x2 cur = {bf2f(a & 0xffffu), bf2f(a >> 16)};
                const f32x2 cv = w0 * h0 + w1 * h1 + w2 * h2 + w3 * cur + bb;
                h0 = h1; h1 = h2; h2 = cur;
                const float y0 = silu_f(cv[0]), y1 = silu_f(cv[1]);
                if (lc < 256) { o0[i] = y0; o1[i] = y1; }
                else { o0[i] = y0; o1[i] = y1; *(unsigned*)(BCN + (size_t)(r0 + t) * 512 + (lc < 384 ? g * 128 + (lc - 256) : 256 + g * 128 + (lc - 384))) = pk2(y0, y1); }
            }
            const int tt = t0 + 8 * tb;
            if (lc < 256) {
                u32x4 u0, u1; u0.x = pk2(o0[0], o0[1]); u0.y = pk2(o0[2], o0[3]); u0.z = pk2(o0[4], o0[5]); u0.w = pk2(o0[6], o0[7]);
                u1.x = pk2(o1[0], o1[1]); u1.y = pk2(o1[2], o1[3]); u1.z = pk2(o1[4], o1[5]); u1.w = pk2(o1[6], o1[7]);
                bf16_t* xg = XTG + ((size_t)ci * 512 + g * 256 + lc) * 128 + tt;
                *(u32x4*)xg = u0; *(u32x4*)(xg + 128) = u1;
                float s0[8], s1[8];
#pragma unroll
                for (int i = 0; i < 8; ++i) { const float w = WG[hl * 128 + tt + i]; s0[i] = o0[i] * w; s1[i] = o1[i] * w; }
                u0.x = pk2(s0[0], s0[1]); u0.y = pk2(s0[2], s0[3]); u0.z = pk2(s0[4], s0[5]); u0.w = pk2(s0[6], s0[7]);
                u1.x = pk2(s1[0], s1[1]); u1.y = pk2(s1[2], s1[3]); u1.z = pk2(s1[4], s1[5]); u1.w = pk2(s1[6], s1[7]);
                *(LAS u32x4*)(XTs + lc * 136 + tt) = u0; *(LAS u32x4*)(XTs + (lc + 1) * 136 + tt) = u1;
            } else if (lc < 384) {
                u32x4 u0, u1; u0.x = pk2(o0[0], o0[1]); u0.y = pk2(o0[2], o0[3]); u0.z = pk2(o0[4], o0[5]); u0.w = pk2(o0[6], o0[7]);
                u1.x = pk2(o1[0], o1[1]); u1.y = pk2(o1[2], o1[3]); u1.z = pk2(o1[4], o1[5]); u1.w = pk2(o1[6], o1[7]);
                *(LAS u32x4*)(BT + (lc - 256) * 136 + tt) = u0; *(LAS u32x4*)(BT + (lc - 255) * 136 + tt) = u1;
            }
        }
        if (c == 63 && th == 1) {
            float* o = P.out + O_PCONV + ((size_t)(l * 4 + (ci >> 6)) * 3) * 1024 + xc;
            *(f32x2*)o = h0; *(f32x2*)(o + 1024) = h1; *(f32x2*)(o + 2048) = h2;
        }
    }
    __syncthreads();
    {
        const int hl = wave >> 1, ph = wave & 1, r = lane & 15, q = lane >> 4;
        f32x4 acc[2][8];
#pragma unroll
        for (int mt = 0; mt < 2; ++mt)
#pragma unroll
            for (int nt = 0; nt < 8; ++nt) acc[mt][nt] = (f32x4){0.f, 0.f, 0.f, 0.f};
#pragma unroll
        for (int ks = 0; ks < 4; ++ks) {
            bf16x8 xf[2];
#pragma unroll
            for (int mt = 0; mt < 2; ++mt) xf[mt] = *(const LAS bf16x8*)(XTs + (hl * 64 + 32 * ph + 16 * mt + r) * 136 + 32 * ks + 8 * q);
#pragma unroll
            for (int nt = 0; nt < 8; ++nt) { const bf16x8 bf = *(const LAS bf16x8*)(BT + (16 * nt + r) * 136 + 32 * ks + 8 * q);
#pragma unroll
                for (int mt = 0; mt < 2; ++mt) acc[mt][nt] = __builtin_amdgcn_mfma_f32_16x16x32_bf16(bf, xf[mt], acc[mt][nt], 0, 0, 0); }
        }
        float* sp = ST + ((size_t)(ci * 8 + 4 * g + hl) * 64) * 128;
#pragma unroll
        for (int mt = 0; mt < 2; ++mt)
#pragma unroll
            for (int nt = 0; nt < 8; ++nt) *(f32x4*)(sp + (size_t)(32 * ph + 16 * mt + r) * 128 + 16 * nt + 4 * q) = acc[mt][nt];
    }
    __syncthreads();
}

__device__ __forceinline__ void attn_prompt_unit(const Params& P, LAS unsigned char* lds, int l, int b, int qb, int kvh) {
    const int tid = opaque_tid(P.pad), lane = tid & 63, wave = tid >> 6;
    const bf16_t* PROJ = (const bf16_t*)(P.ws + WS_PROJ); bf16_t* YCAT = (bf16_t*)(P.ws + WS_YCAT);
    LAS bf16_t* Ks = (LAS bf16_t*)lds;
    LAS bf16_t* VT = (LAS bf16_t*)(lds + 36864);
    const int r1 = b * 8192 + qb * 128;
    u32x4 qa[4], qb4[4];
    {
        const int g = wave >> 1, qh = wave & 1, r = lane & 15, q = lane >> 4, head = kvh * 4 + g;
#pragma unroll
        for (int it = 0; it < 4; ++it) { const bf16_t* qp = PROJ + (size_t)(r1 + 64 * qh + 16 * it + r) * NPROJ + PC_Q + head * 64;
            qa[it] = *(const u32x4*)(qp + 8 * q); qb4[it] = *(const u32x4*)(qp + 32 + 8 * q); }
    }
    {
        const int key = tid >> 1, half = tid & 1; const int row = r1 - 128 + key; const bool ok = (qb > 0) || (key >= 128);
        float kx[32], vx[32];
        if (ok) {
            const bf16_t* kp = PROJ + (size_t)row * NPROJ + PC_K + kvh * 64 + 32 * half; const bf16_t* vp = PROJ + (size_t)row * NPROJ + PC_V + kvh * 64 + 32 * half;
#pragma unroll
            for (int i = 0; i < 4; ++i) { const u32x4 a = *(const u32x4*)(kp + 8 * i), v = *(const u32x4*)(vp + 8 * i);
#pragma unroll
                for (int e = 0; e < 4; ++e) { kx[8 * i + 2 * e] = bf2f(a[e] & 0xffffu); kx[8 * i + 2 * e + 1] = bf2f(a[e] >> 16); vx[8 * i + 2 * e] = bf2f(v[e] & 0xffffu); vx[8 * i + 2 * e + 1] = bf2f(v[e] >> 16); } }
        } else {
#pragma unroll
            for (int i = 0; i < 32; ++i) { kx[i] = 0.f; vx[i] = 0.f; }
        }
        float ss = 0.f;
#pragma unroll
        for (int i = 0; i < 32; ++i) ss += kx[i] * kx[i];
        ss += shx(ss, 1, lane);
        const float rs = rsqrtf(ss * (1.f / 64.f) + EPS);
        const float* kw = P.in[I_KN] + l * 64 + 32 * half;
#pragma unroll
        for (int i = 0; i < 32; ++i) kx[i] = kx[i] * rs * kw[i];
#pragma unroll
        for (int i = 0; i < 4; ++i) { u32x4 w; w.x = pk2(kx[8 * i], kx[8 * i + 1]); w.y = pk2(kx[8 * i + 2], kx[8 * i + 3]); w.z = pk2(kx[8 * i + 4], kx[8 * i + 5]); w.w = pk2(kx[8 * i + 6], kx[8 * i + 7]);
            *(LAS u32x4*)(Ks + key * 72 + 32 * half + 8 * i) = w; }
#pragma unroll
        for (int i = 0; i < 32; ++i) VT[(32 * half + i) * 264 + key] = (bf16_t)(pk2(vx[i], 0.f) & 0xffffu);
        if (qb == 63 && key >= 128) {
            float* ko = P.out + O_PK + (((size_t)(l * 4 + b) * 128 + (key - 128)) * 2 + kvh) * 64 + 32 * half; float* vo = P.out + O_PV + (((size_t)(l * 4 + b) * 128 + (key - 128)) * 2 + kvh) * 64 + 32 * half;
#pragma unroll
            for (int i = 0; i < 8; ++i) { *(f32x4*)(ko + 4 * i) = (f32x4){kx[4 * i], kx[4 * i + 1], kx[4 * i + 2], kx[4 * i + 3]}; *(f32x4*)(vo + 4 * i) = (f32x4){vx[4 * i], vx[4 * i + 1], vx[4 * i + 2], vx[4 * i + 3]}; }
        }
    }
    __syncthreads();
    {
        const int g = wave >> 1, qh = wave & 1, r = lane & 15, q = lane >> 4, head = kvh * 4 + g;
        const float slope = exp2f(-(float)(head + 1)), sink = P.in[I_SINK][l * 8 + head];
#pragma unroll
        for (int it = 0; it < 4; ++it) {
            const int i0 = 64 * qh + 16 * it; const int row = r1 + i0 + r;
            __builtin_amdgcn_sched_barrier(0);
            attn_tile(qa[it], qb4[it], P.in[I_QN] + l * 64, Ks, VT, i0, r + 128, (qb > 0) ? 0 : 128 - i0, 144, slope, sink,
                      YCAT + (size_t)row * DM + 512 + head * 64, r, q);
        }
    }
    __syncthreads();
}

__device__ __forceinline__ void ssd_sample_unit(const Params& P, LAS unsigned char* lds, int l, int b, int g) {
    const int tid = opaque_tid(P.pad);
    const bf16_t* PROJ = (const bf16_t*)(P.ws + WS_PROJ); const float* DT = (const float*)(P.ws + WS_DT); bf16_t* YCAT = (bf16_t*)(P.ws + WS_YCAT);
    LAS float* XV = (LAS float*)lds;
    LAS float* YZ = (LAS float*)(lds + 8192);
    LAS float* RS = (LAS float*)(lds + 12288);
    const int rs0 = MP + 4 * b;
    {
        const int lc = tid; int xc; if (lc < 256) xc = g * 256 + lc; else if (lc < 384) xc = 512 + g * 128 + (lc - 256); else xc = 768 + g * 128 + (lc - 384);
        const float* cw = P.in[I_CW] + (size_t)l * 4 * 1024 + xc; const float w0 = cw[0], w1 = cw[1024], w2 = cw[2048], w3 = cw[3072], bb = P.in[I_CB][l * 1024 + xc];
        const float* sp = P.in[I_SCONV] + ((size_t)(l * 128 + b) * 3) * 1024 + xc;
        float h0 = sp[0], h1 = sp[1024], h2 = sp[2048];
#pragma unroll
        for (int t = 0; t < 4; ++t) {
            const float cur = bf2f(PROJ[(size_t)(rs0 + t) * NPROJ + PC_XBC + xc]);
            const float cv = w0 * h0 + w1 * h1 + w2 * h2 + w3 * cur + bb;
            h0 = h1; h1 = h2; h2 = cur;
            XV[t * 512 + lc] = silu_f(cv);
        }
        float* o = P.out + O_SCONV + ((size_t)(l * 128 + b) * 3) * 1024 + xc; o[0] = h0; o[1024] = h1; o[2048] = h2;
    }
    __syncthreads();
    {
        const int hl = tid >> 7, p = (tid & 127) >> 1, nh = tid & 1, h = 4 * g + hl, lane = tid & 63;
        const float a = -__expf(P.in[I_ALOG][l * 8 + h]), dsk = P.in[I_DSKIP][l * 8 + h];
        const float* sin_ = P.in[I_SSM] + (((size_t)(l * 128 + b) * 8 + h) * 64 + p) * 128 + 64 * nh;
        float* sout = P.out + O_SSSM + (((size_t)(l * 128 + b) * 8 + h) * 64 + p) * 128 + 64 * nh;
        f32x4 st[16];
#pragma unroll
        for (int i = 0; i < 16; ++i) st[i] = *(const f32x4*)(sin_ + 4 * i);
        float dtv[4], zv[4];
#pragma unroll
        for (int t = 0; t < 4; ++t) { dtv[t] = DT[(size_t)(rs0 + t) * 8 + h]; zv[t] = bf2f(PROJ[(size_t)(rs0 + t) * NPROJ + PC_Z + h * 64 + p]); }
#pragma unroll
        for (int t = 0; t < 4; ++t) {
            const float dt = dtv[t], dA = __expf(dt * a), x = XV[t * 512 + hl * 64 + p], xdt = x * dt;
            float y = 0.f;
#pragma unroll
            for (int i = 0; i < 16; ++i) { const f32x4 bv = *(const LAS f32x4*)(XV + t * 512 + 256 + 64 * nh + 4 * i), cv = *(const LAS f32x4*)(XV + t * 512 + 384 + 64 * nh + 4 * i);
                st[i] = st[i] * dA + xdt * bv; y += (st[i][0] * cv[0] + st[i][1] * cv[1]) + (st[i][2] * cv[2] + st[i][3] * cv[3]); }
            y += shx(y, 1, lane);
            y += dsk * x;
            const float z = zv[t];
            if (nh == 0) YZ[t * 256 + hl * 64 + p] = y * silu_f(z);
        }
#pragma unroll
        for (int i = 0; i < 16; ++i) *(f32x4*)(sout + 4 * i) = st[i];
    }
    __syncthreads();
    {
        const int wave = tid >> 6, lane = tid & 63;
        if (wave < 4) { float s = 0.f;
#pragma unroll
            for (int i = 0; i < 4; ++i) { const float v = YZ[wave * 256 + lane + 64 * i]; s += v * v; }
            s = wave_sum(s, lane); if (lane == 0) RS[wave] = rsqrtf(s * (1.f / 256.f) + EPS); }
    }
    __syncthreads();
    for (int e = tid; e < 1024; e += 512) { const int t = e >> 8, ch = e & 255;
        YCAT[(size_t)(rs0 + t) * DM + g * 256 + ch] = (bf16_t)(pk2(YZ[e] * RS[t] * P.in[I_SNORM][l * 512 + g * 256 + ch], 0.f) & 0xffffu); }
    __syncthreads();
}

__device__ __forceinline__ void attn_sample_unit(const Params& P, LAS unsigned char* lds, int l, int b, int kvh) {
    const int tid = opaque_tid(P.pad), lane = tid & 63, wave = tid >> 6;
    const bf16_t* PROJ = (const bf16_t*)(P.ws + WS_PROJ); bf16_t* YCAT = (bf16_t*)(P.ws + WS_YCAT);
    LAS bf16_t* Ks = (LAS bf16_t*)lds; LAS bf16_t* VT = (LAS bf16_t*)(lds + 36864);
    const int rs0 = MP + 4 * b;
    {
        const int key = tid >> 2, qt = tid & 3;
        const float* kp = P.in[I_CK] + (((size_t)(l * 128 + b) * 128 + key) * 2 + kvh) * 64 + 16 * qt; const float* vp = P.in[I_CV] + (((size_t)(l * 128 + b) * 128 + key) * 2 + kvh) * 64 + 16 * qt;
        f32x4 k4[4], v4[4];
#pragma unroll
        for (int i = 0; i < 4; ++i) { k4[i] = *(const f32x4*)(kp + 4 * i); v4[i] = *(const f32x4*)(vp + 4 * i); }
        *(LAS u32x4*)(Ks + key * 72 + 16 * qt) = __builtin_bit_cast(u32x4, cvt8(k4[0], k4[1])); *(LAS u32x4*)(Ks + key * 72 + 16 * qt + 8) = __builtin_bit_cast(u32x4, cvt8(k4[2], k4[3]));
#pragma unroll
        for (int i = 0; i < 4; ++i)
#pragma unroll
            for (int e = 0; e < 4; ++e) VT[(16 * qt + 4 * i + e) * 264 + key] = (bf16_t)(pk2(v4[i][e], 0.f) & 0xffffu);
        if (key >= 4) {
            float* ko = P.out + O_SK + (((size_t)(l * 128 + b) * 128 + (key - 4)) * 2 + kvh) * 64 + 16 * qt; float* vo = P.out + O_SV + (((size_t)(l * 128 + b) * 128 + (key - 4)) * 2 + kvh) * 64 + 16 * qt;
#pragma unroll
            for (int i = 0; i < 4; ++i) { *(f32x4*)(ko + 4 * i) = k4[i]; *(f32x4*)(vo + 4 * i) = v4[i]; }
        }
    }
    if (tid < 64) {
        const int t = tid >> 4, d4 = (tid & 15) * 4;
        const bf16_t* kp = PROJ + (size_t)(rs0 + t) * NPROJ + PC_K + kvh * 64 + d4; const bf16_t* vp = PROJ + (size_t)(rs0 + t) * NPROJ + PC_V + kvh * 64 + d4;
        const u32x2 a = *(const u32x2*)kp, v = *(const u32x2*)vp;
        float kx[4] = {bf2f(a.x & 0xffffu), bf2f(a.x >> 16), bf2f(a.y & 0xffffu), bf2f(a.y >> 16)}, vx[4] = {bf2f(v.x & 0xffffu), bf2f(v.x >> 16), bf2f(v.y & 0xffffu), bf2f(v.y >> 16)};
        float ss = (kx[0] * kx[0] + kx[1] * kx[1]) + (kx[2] * kx[2] + kx[3] * kx[3]);
        ss += shx(ss, 1, lane); ss += shx(ss, 2, lane); ss += shx(ss, 4, lane); ss += shx(ss, 8, lane);
        const float rs = rsqrtf(ss * (1.f / 64.f) + EPS);
        const f32x4 kw = *(const f32x4*)(P.in[I_KN] + l * 64 + d4);
#pragma unroll
        for (int e = 0; e < 4; ++e) kx[e] = kx[e] * rs * kw[e];
        u32x2 w; w.x = pk2(kx[0], kx[1]); w.y = pk2(kx[2], kx[3]); *(LAS u32x2*)(Ks + (128 + t) * 72 + d4) = w;
#pragma unroll
        for (int e = 0; e < 4; ++e) VT[(d4 + e) * 264 + 128 + t] = (bf16_t)(pk2(vx[e], 0.f) & 0xffffu);
        float* ko = P.out + O_SK + (((size_t)(l * 128 + b) * 128 + (124 + t)) * 2 + kvh) * 64 + d4; float* vo = P.out + O_SV + (((size_t)(l * 128 + b) * 128 + (124 + t)) * 2 + kvh) * 64 + d4;
        *(f32x4*)ko = (f32x4){kx[0], kx[1], kx[2], kx[3]}; *(f32x4*)vo = (f32x4){vx[0], vx[1], vx[2], vx[3]};
    } else if (tid < 128) {
        const int e = tid - 64;
        for (int i = e; i < 12 * 64; i += 64) Ks[(132 + i / 64) * 72 + (i & 63)] = 0;
        for (int i = e; i < 64 * 12; i += 64) VT[(i / 12) * 264 + 132 + (i % 12)] = 0;
    }
    __syncthreads();
    if (wave == 0) {
        const int r = lane & 15, q = lane >> 4, g = r >> 2, t = r & 3, head = kvh * 4 + g;
        const float slope = exp2f(-(float)(head + 1)), sink = P.in[I_SINK][l * 8 + head];
        const bf16_t* qp = PROJ + (size_t)(rs0 + t) * NPROJ + PC_Q + head * 64;
        attn_tile(*(const u32x4*)(qp + 8 * q), *(const u32x4*)(qp + 32 + 8 * q), P.in[I_QN] + l * 64, Ks, VT, 0, t + 128, 0, 132, slope, sink,
                  YCAT + (size_t)(rs0 + t) * DM + 512 + head * 64, r, q);
    }
    __syncthreads();
}

__device__ __forceinline__ void phase_scan(const Params& P, int l) {
    const float* ST = (const float*)(P.ws + WS_ST); const float* CD = (const float*)(P.ws + WS_CD); bf16_t* PB = (bf16_t*)(P.ws + WS_PSTB);
    for (int idx = blockIdx.x * 512 + opaque_tid(P.pad); idx < 131072; idx += gridDim.x * 512) {
        const int b = idx >> 15, rem = idx & 32767, h = rem >> 12, e2 = rem & 4095;
        f32x2 carry = {0.f, 0.f};
        for (int c0 = 0; c0 < 64; c0 += 16) {
            f32x2 v[16]; float dc[16];
#pragma unroll
            for (int i = 0; i < 16; ++i) { v[i] = *(const f32x2*)(ST + ((size_t)((b * 64 + c0 + i) * 8 + h)) * 8192 + 2 * e2); dc[i] = CD[(b * 64 + c0 + i) * 8 + h]; }
#pragma unroll
            for (int i = 0; i < 16; ++i) { *(unsigned*)(PB + ((size_t)((b * 64 + c0 + i) * 8 + h)) * 8192 + 2 * e2) = pk2(carry[0], carry[1]); carry = carry * dc[i] + v[i]; }
        }
        *(f32x2*)(P.out + O_PSSM + ((size_t)((l * 4 + b) * 8 + h)) * 8192 + 2 * e2) = carry;
    }
}

__device__ __forceinline__ void ssd_out_unit(const Params& P, LAS unsigned char* lds, int l, int ci, int g) {
    const int tid = opaque_tid(P.pad), lane = tid & 63, wave = tid >> 6;
    const bf16_t* PROJ = (const bf16_t*)(P.ws + WS_PROJ); const float* DT = (const float*)(P.ws + WS_DT); const float* AC = (const float*)(P.ws + WS_AC);
    const bf16_t* XTG = (const bf16_t*)(P.ws + WS_XTG); const bf16_t* BCN = (const bf16_t*)(P.ws + WS_BCN); const bf16_t* PB = (const bf16_t*)(P.ws + WS_PSTB);
    bf16_t* YCAT = (bf16_t*)(P.ws + WS_YCAT);
    LAS bf16_t* XT = (LAS bf16_t*)lds;
    LAS bf16_t* Bn = (LAS bf16_t*)(lds + 69632);
    LAS bf16_t* Cn = (LAS bf16_t*)(lds + 104448);
    LAS float* ACs = (LAS float*)(lds + 139264);
    LAS float* DTs = (LAS float*)(lds + 141312);
    const int r0 = ci * 128;
    for (int e = tid; e < 4096; e += 512) { const int row = e >> 4, pc = e & 15; *(LAS u32x4*)(XT + row * 136 + 8 * pc) = *(const u32x4*)(XTG + ((size_t)ci * 512 + g * 256 + row) * 128 + 8 * pc); }
    for (int e = tid; e < 2048; e += 512) { const int row = e >> 4, pc = e & 15;
        *(LAS u32x4*)(Bn + row * 136 + 8 * pc) = *(const u32x4*)(BCN + (size_t)(r0 + row) * 512 + g * 128 + 8 * pc);
        *(LAS u32x4*)(Cn + row * 136 + 8 * pc) = *(const u32x4*)(BCN + (size_t)(r0 + row) * 512 + 256 + g * 128 + 8 * pc); }
    { const int hl = tid >> 7, t = tid & 127; ACs[hl * 128 + t] = AC[(size_t)(r0 + t) * 8 + 4 * g + hl]; DTs[hl * 128 + t] = DT[(size_t)(r0 + t) * 8 + 4 * g + hl]; }
    __syncthreads();
    {
        const int nt = wave, r = lane & 15, q = lane >> 4, lrow = 16 * nt + r;
        bf16x8 cf[4];
#pragma unroll
        for (int ks = 0; ks < 4; ++ks) cf[ks] = *(const LAS bf16x8*)(Cn + lrow * 136 + 32 * ks + 8 * q);
        f32x4 gt[8];
#pragma unroll
        for (int st = 0; st < 8; ++st) {
            gt[st] = (f32x4){0.f, 0.f, 0.f, 0.f};
            if ((st & 1) == 0) __builtin_amdgcn_sched_barrier(0);
            if (st <= nt) {
#pragma unroll
                for (int ks = 0; ks < 4; ++ks) gt[st] = __builtin_amdgcn_mfma_f32_16x16x32_bf16(*(const LAS bf16x8*)(Bn + (16 * st + r) * 136 + 32 * ks + 8 * q), cf[ks], gt[st], 0, 0, 0);
            }
        }
        float ss = 0.f;
        const int grow = r0 + lrow;
        __syncthreads();
        LAS bf16_t* YL = (LAS bf16_t*)(lds + 69632);
#pragma unroll 1
        for (int hl = 0; hl < 4; ++hl) {
            const int h = 4 * g + hl;
            __builtin_amdgcn_sched_barrier(0);
            f32x4 acc[4], aco[4];
#pragma unroll
            for (int mt = 0; mt < 4; ++mt) { acc[mt] = (f32x4){0.f, 0.f, 0.f, 0.f}; aco[mt] = (f32x4){0.f, 0.f, 0.f, 0.f}; }
            const bf16_t* pv = PB + ((size_t)(ci * 8 + h) * 64) * 128;
            bf16x8 pf[2][4];
#pragma unroll
            for (int ks = 0; ks < 2; ++ks)
#pragma unroll
                for (int mt = 0; mt < 4; ++mt) pf[ks][mt] = *(const bf16x8*)(pv + (size_t)(16 * mt + r) * 128 + 32 * ks + 8 * q);
            u32x2 zzv[4];
#pragma unroll
            for (int mt = 0; mt < 4; ++mt) zzv[mt] = *(const u32x2*)(PROJ + (size_t)grow * NPROJ + PC_Z + h * 64 + 16 * mt + 4 * q);
            const float dsk = P.in[I_DSKIP][l * 8 + h];
            const float al = ACs[hl * 128 + lrow], el = __expf(al);
#pragma unroll
            for (int kk = 0; kk < 4; ++kk) {
                __builtin_amdgcn_sched_barrier(0);
                if (kk == 2) {
#pragma unroll
                    for (int ks = 0; ks < 2; ++ks)
#pragma unroll
                        for (int mt = 0; mt < 4; ++mt) aco[mt] = __builtin_amdgcn_mfma_f32_16x16x32_bf16(pf[ks][mt], cf[ks], aco[mt], 0, 0, 0);
#pragma unroll
                    for (int ks = 0; ks < 2; ++ks)
#pragma unroll
                        for (int mt = 0; mt < 4; ++mt) pf[ks][mt] = *(const bf16x8*)(pv + (size_t)(16 * mt + r) * 128 + 32 * (ks + 2) + 8 * q);
                    __builtin_amdgcn_sched_barrier(0);
                }
                if (2 * kk <= nt) {
                    f32x4 wv[2];
#pragma unroll
                    for (int hf = 0; hf < 2; ++hf) { const int st = 2 * kk + hf;
                        const f32x4 as = *(const LAS f32x4*)(ACs + hl * 128 + 16 * st + 4 * q), ds = *(const LAS f32x4*)(DTs + hl * 128 + 16 * st + 4 * q);
#pragma unroll
                        for (int j = 0; j < 4; ++j) { const int s = 16 * st + 4 * q + j; wv[hf][j] = (s <= lrow) ? gt[st][j] * __expf(al - as[j]) * ds[j] : 0.f; } }
                    const bf16x8 wf = cvt8(wv[0], wv[1]);
#pragma unroll
                    for (int mt = 0; mt < 4; ++mt) { const LAS bf16_t* xp = XT + (hl * 64 + 16 * mt + r) * 136 + 32 * kk + 4 * q;
                        const u32x2 lo = *(const LAS u32x2*)xp, hi = *(const LAS u32x2*)(xp + 16); u32x4 w; w.x = lo.x; w.y = lo.y; w.z = hi.x; w.w = hi.y;
                        acc[mt] = __builtin_amdgcn_mfma_f32_16x16x32_bf16(__builtin_bit_cast(bf16x8, w), wf, acc[mt], 0, 0, 0); }
                }
            }
            __builtin_amdgcn_sched_barrier(0);
#pragma unroll
            for (int ks = 0; ks < 2; ++ks)
#pragma unroll
                for (int mt = 0; mt < 4; ++mt) aco[mt] = __builtin_amdgcn_mfma_f32_16x16x32_bf16(pf[ks][mt], cf[ks + 2], aco[mt], 0, 0, 0);
#pragma unroll
            for (int mt = 0; mt < 4; ++mt) acc[mt] = acc[mt] + aco[mt] * el;
#pragma unroll
            for (int mt = 0; mt < 4; ++mt) { const u32x2 zz = zzv[mt];
                const float z[4] = {bf2f(zz.x & 0xffffu), bf2f(zz.x >> 16), bf2f(zz.y & 0xffffu), bf2f(zz.y >> 16)};
                float yv[4];
#pragma unroll
                for (int j = 0; j < 4; ++j) { const float x = bf2f(XT[(hl * 64 + 16 * mt + 4 * q + j) * 136 + lrow]); const float y = (acc[mt][j] + dsk * x) * silu_f(z[j]); yv[j] = y; ss += y * y; }
                u32x2 yo; yo.x = pk2(yv[0], yv[1]); yo.y = pk2(yv[2], yv[3]); *(LAS u32x2*)(YL + lrow * 264 + hl * 64 + 16 * mt + 4 * q) = yo; }
        }
        ss += shx(ss, 16, lane); ss += shx(ss, 32, lane);
        const float rstd = rsqrtf(ss * (1.f / 256.f) + EPS);
        const float* nw = P.in[I_SNORM] + l * 512 + g * 256;
        const int piece = lane & 31, rsub = lane >> 5;
        const f32x4 w0 = *(const f32x4*)(nw + 8 * piece), w1 = *(const f32x4*)(nw + 8 * piece + 4);
#pragma unroll
        for (int ps = 0; ps < 8; ++ps) {
            const int rr = 2 * ps + rsub; const float rs = shi(rstd, rr);
            const u32x4 yv = *(const LAS u32x4*)(YL + (16 * nt + rr) * 264 + 8 * piece);
            u32x4 o; o.x = pk2(bf2f(yv.x & 0xffffu) * rs * w0[0], bf2f(yv.x >> 16) * rs * w0[1]); o.y = pk2(bf2f(yv.y & 0xffffu) * rs * w0[2], bf2f(yv.y >> 16) * rs * w0[3]);
            o.z = pk2(bf2f(yv.z & 0xffffu) * rs * w1[0], bf2f(yv.z >> 16) * rs * w1[1]); o.w = pk2(bf2f(yv.w & 0xffffu) * rs * w1[2], bf2f(yv.w >> 16) * rs * w1[3]);
            *(u32x4*)(YCAT + (size_t)(r0 + 16 * nt + rr) * DM + g * 256 + 8 * piece) = o;
        }
    }
    __syncthreads();
}

__device__ __forceinline__ void phase_fixup(const Params& P, int l) {
    const bf16_t* UH = (const bf16_t*)(P.ws + WS_UH); bf16_t* G = (bf16_t*)(P.ws + WS_G);
    const float* cw = P.in[I_FCW] + (size_t)l * 3 * NUP; const float* cb = P.in[I_FCB] + (size_t)l * NUP;
    const float* US = (const float*)(P.ws + WS_US);
#pragma unroll 1
    for (int part = 0; part < 2; ++part) {
    if ((part ^ (int)(blockIdx.x & 1)) == 0)
    for (int gi = blockIdx.x; gi < 512; gi += gridDim.x) {
        const bool first = (gi & 127) == 0;
        const bf16_t* cur = UH + (size_t)gi * 4 * NUP; const bf16_t* prv = UH + (size_t)(gi - 1) * 4 * NUP;
        for (int j4 = opaque_tid(P.pad); j4 < DFF / 4; j4 += 512) {
            const int j = 4 * j4;
            f32x4 cvv[2][2];
#pragma unroll
            for (int gv = 0; gv < 2; ++gv) { const int c = j + gv * DFF;
                const f32x4 w0 = *(const f32x4*)(cw + c), w1 = *(const f32x4*)(cw + NUP + c), w2 = *(const f32x4*)(cw + 2 * NUP + c), bb = *(const f32x4*)(cb + c);
                const u32x2 a0 = *(const u32x2*)(cur + c), a1 = *(const u32x2*)(cur + NUP + c);
                u32x2 p2 = {0u, 0u}, p1 = {0u, 0u}; if (!first) { p2 = *(const u32x2*)(prv + 2 * NUP + c); p1 = *(const u32x2*)(prv + 3 * NUP + c); }
                const f32x4 u0 = {bf2f(a0.x & 0xffffu), bf2f(a0.x >> 16), bf2f(a0.y & 0xffffu), bf2f(a0.y >> 16)}, u1 = {bf2f(a1.x & 0xffffu), bf2f(a1.x >> 16), bf2f(a1.y & 0xffffu), bf2f(a1.y >> 16)};
                const f32x4 pm2 = {bf2f(p2.x & 0xffffu), bf2f(p2.x >> 16), bf2f(p2.y & 0xffffu), bf2f(p2.y >> 16)}, pm1 = {bf2f(p1.x & 0xffffu), bf2f(p1.x >> 16), bf2f(p1.y & 0xffffu), bf2f(p1.y >> 16)};
                cvv[0][gv] = w0 * pm2 + w1 * pm1 + w2 * u0 + bb; cvv[1][gv] = w0 * pm1 + w1 * u0 + w2 * u1 + bb; }
#pragma unroll
            for (int rr = 0; rr < 2; ++rr) { u32x2 o; o.x = pk2(silu_f(cvv[rr][0][0]) * cvv[rr][1][0], silu_f(cvv[rr][0][1]) * cvv[rr][1][1]); o.y = pk2(silu_f(cvv[rr][0][2]) * cvv[rr][1][2], silu_f(cvv[rr][0][3]) * cvv[rr][1][3]);
                *(u32x2*)(G + (size_t)(64 * gi + rr) * DFF + j) = o; }
        }
        if ((gi & 127) == 127) { float* o = P.out + O_PFFN + ((size_t)(l * 4 + (gi >> 7)) * 2) * NUP;
            for (int c = opaque_tid(P.pad); c < 2 * NUP; c += 512) o[c] = bf2f(cur[2 * NUP + c]); }
    }
    else
    for (int hb = blockIdx.x; hb < 256; hb += gridDim.x) {
        const int b = hb >> 1, jlo = (hb & 1) * (DFF / 2);
        const float* sp = P.in[I_SFFN] + ((size_t)(l * 128 + b) * 2) * NUP; float* sn = P.out + O_SFFN + ((size_t)(l * 128 + b) * 2) * NUP;
        const float* ub = US + (size_t)(4 * b) * NUP;
        for (int j = jlo + opaque_tid(P.pad); j < jlo + DFF / 2; j += 512) {
            float cv[4][2];
#pragma unroll
            for (int gv = 0; gv < 2; ++gv) { const int c = j + gv * DFF;
                const float w0 = cw[c], w1 = cw[NUP + c], w2 = cw[2 * NUP + c], bb = cb[c];
                const float s0 = sp[c], s1 = sp[NUP + c]; float u0 = 0.f, u1 = 0.f, u2 = 0.f, u3 = 0.f;
#pragma unroll
                for (int k = 0; k < 2; ++k) { const float* uk = ub + (size_t)k * MS * NUP; u0 += uk[c]; u1 += uk[NUP + c]; u2 += uk[2 * NUP + c]; u3 += uk[3 * NUP + c]; }
                cv[0][gv] = w0 * s0 + w1 * s1 + w2 * u0 + bb; cv[1][gv] = w0 * s1 + w1 * u0 + w2 * u1 + bb;
                cv[2][gv] = w0 * u0 + w1 * u1 + w2 * u2 + bb; cv[3][gv] = w0 * u1 + w1 * u2 + w2 * u3 + bb;
                sn[c] = u2; sn[NUP + c] = u3; }
#pragma unroll
            for (int t = 0; t < 4; ++t) G[(size_t)(MP + 4 * b + t) * DFF + j] = (bf16_t)(pk2(silu_f(cv[t][0]) * cv[t][1], 0.f) & 0xffffu);
        }
    }
    }
}

__device__ __forceinline__ void phase_final(const Params& P) {
    const int tid = opaque_tid(P.pad);
    for (int i = blockIdx.x * 512 + tid; i < MS * DM / 4; i += gridDim.x * 512) {
        f32x4 v = *(const f32x4*)((const float*)(P.ws + WS_XS) + 4 * i);
        for (int k = 0; k < 11; ++k) v = v + *(const f32x4*)((const float*)(P.ws + WS_XSL) + (size_t)k * MS * DM + 4 * i);
        *(f32x4*)(P.out + (size_t)MP * DM + 4 * i) = v;
    }
}
#define XB_TMO      128
#define XB_XCNT(j)  (256  + 64 * (j))
#define XB_XSUB(j)  (1280 + 64 * (j))
#define XB_XGEN(j)  (2304 + 64 * (j))
#define XB_TOP      3328
#define XB_TOPGEN   3392
#define XCD_BAR_WORDS 3456
#define XB_SPIN_CAP (1u << 18)


__device__ __forceinline__ unsigned xb_ld(unsigned* p)              { return __hip_atomic_load(p, __ATOMIC_RELAXED, __HIP_MEMORY_SCOPE_AGENT); }
__device__ __forceinline__ unsigned xb_add(unsigned* p, unsigned v) { return __hip_atomic_fetch_add(p, v, __ATOMIC_RELAXED, __HIP_MEMORY_SCOPE_AGENT); }
__device__ __forceinline__ unsigned xb_xcc_id() { return (unsigned)__builtin_amdgcn_s_getreg((3 << 11) | 20) & 0xFu; }
#define XB_SPIN(cond, bar) do { unsigned _sp = 0; while (cond) { __builtin_amdgcn_s_sleep(1); \
    if ((++_sp & 255u) == 0u) { if (xb_ld(&(bar)[XB_TMO])) break; if (_sp > XB_SPIN_CAP) { atomicAdd(&(bar)[XB_TMO], 1u); break; } } } } while (0)

struct XcdBarrier {
    unsigned* bar; unsigned x;
    volatile LAS unsigned* st;
};

__device__ __forceinline__ XcdBarrier xcd_barrier_post(unsigned* bar, volatile LAS unsigned* st, bool t0) {
    XcdBarrier b; b.bar = bar; b.x = xb_xcc_id(); b.st = st;
    if (t0) (void)xb_add(&bar[XB_XCNT(b.x)], 1u);
    return b;
}
__device__ __forceinline__ void xcd_barrier_complete(unsigned* bar, unsigned x, unsigned& nloc, unsigned& nx) {
    const unsigned G = gridDim.x * gridDim.y * gridDim.z;
    unsigned sum, cnt, mine, sp = 0u;
    for (;;) {
        sum = 0u; cnt = 0u; mine = 0u;
#pragma unroll
        for (unsigned j = 0; j < 16; ++j) { const unsigned c = xb_ld(&bar[XB_XCNT(j)]); sum += c; cnt += (c > 0u) ? 1u : 0u; mine = (j == x) ? c : mine; }
        if (sum == G) break;
        __builtin_amdgcn_s_sleep(1);
        if ((++sp & 255u) == 0u) { if (xb_ld(&bar[XB_TMO])) break; if (sp > XB_SPIN_CAP) { atomicAdd(&bar[XB_TMO], 1u); break; } }
    }
    nloc = mine > 0u ? mine : 1u; nx = cnt > 0u ? cnt : 1u;
}

__device__ __forceinline__ void xcd_barrier(const XcdBarrier& b, bool t0) {
    asm volatile("s_waitcnt vmcnt(0)" ::: "memory");
    __syncthreads();
    if (t0) {
        unsigned* bar = b.bar;
        __builtin_amdgcn_s_waitcnt(0);
        unsigned nloc = b.st[0], nx = b.st[1];
        if (nloc == 0u) { xcd_barrier_complete(bar, b.x, nloc, nx); b.st[0] = nloc; b.st[1] = nx; }
        const unsigned old = xb_add(&bar[XB_XSUB(b.x)], 1u);
        const unsigned gen = old / nloc;
        if (old + 1u == (gen + 1u) * nloc) {
            __builtin_amdgcn_fence(__ATOMIC_RELEASE, "agent");
            asm volatile("s_waitcnt vmcnt(0)" ::: "memory");
            const unsigned og = xb_add(&bar[XB_TOP], 1u);
            const unsigned tg = og / nx;
            if (og + 1u == (tg + 1u) * nx) xb_add(&bar[XB_TOPGEN], 1u);
            else XB_SPIN(xb_ld(&bar[XB_TOPGEN]) == tg, bar);
            __builtin_amdgcn_fence(__ATOMIC_ACQUIRE, "agent");
            xb_add(&bar[XB_XGEN(b.x)], 1u);
            asm volatile("s_waitcnt vmcnt(0)" ::: "memory");
        } else {
            XB_SPIN(xb_ld(&bar[XB_XGEN(b.x)]) == gen, bar);
            __builtin_amdgcn_fence(__ATOMIC_ACQUIRE, "agent");
            asm volatile("s_waitcnt vmcnt(0)" ::: "memory");
        }
    }
    __syncthreads();
}


constexpr int N_PHASES = 22;
#ifndef ONLY_K
#define ONLY_K -1
#endif
#ifndef ONLY_U
#define ONLY_U -1
#endif
#define ENU(uu) (ONLY_U < 0 || ONLY_U == (uu))
#define EN(kk) (ONLY_K < 0 || ONLY_K == (kk))
__global__ void __launch_bounds__(512, 2) fwd_megakernel(Params Pk) {
    Params P = Pk; P.pad = __builtin_amdgcn_readfirstlane((int)threadIdx.x & ~63);
    extern __shared__ __attribute__((aligned(16))) unsigned char lds_raw[];
    LAS unsigned char* lds = (LAS unsigned char*)lds_raw;
    cg::grid_group grid = cg::this_grid();
    volatile LAS unsigned* stw = (volatile LAS unsigned*)(lds + LDS_BYTES - 16);
    { const int t = opaque_tid(P.pad); if (t < 4) stw[t] = 0u; }
    __syncthreads();
    const XcdBarrier bar = xcd_barrier_post((unsigned*)(P.ws + WS_CTL), stw, opaque_tid(P.pad) == 0);
    float* X = P.out;
    for (int ph = P.ph_lo; ph < P.ph_hi; ++ph) {
        if (ph == 0) { if (!(blockIdx.x & 1)) { if (EN(10)) phase_weights(P, lds); __syncthreads(); } }
        else if (ph == 21) phase_final(P);
        else {
            int phv = ph, gdim = gridDim.x, bidx = blockIdx.x; asm volatile("" : "+s"(phv), "+s"(gdim), "+s"(bidx));
            const int l = (phv - 1) / 10, k = (phv - 1) % 10;
            void* XB1 = (void*)(P.ws + WS_XB); void* XB2 = (void*)P.out; const float* XS = (const float*)(P.ws + WS_XS);
            const void* xin = (l == 0) ? (const void*)P.in[I_XP] : (const void*)XB2;
            if (k == 0) { if (EN(0)) phase_norm<true>(P, lds, l, xin, l != 0, l == 0 ? P.in[I_XS] : XS, P.in[I_N1] + l * DM, l == 0 ? 0 : 11);
                if (l == 0 && (bidx & 1)) { __syncthreads(); if (EN(10)) phase_weights(P, lds); } }
            else if (k == 1 && EN(1)) {
                pg8::Gemm g{(const bf16_t*)(P.ws + WS_HN), (const bf16_t*)(P.ws + WS_WIN + l * WIN_L), MT, NPROJ, DM, P.pad, P.rep == 2}; pg8::StaticOrder S; S.init(MT, NPROJ, DM, gdim, bidx);
                pg8::EpiProj E{(bf16_t*)(P.ws + WS_PROJ), NPROJ, P.rep == 3};
                pg8::gemm_phase<pg8::EpiProj, pg8::StaticOrder, false>(lds, g, S, E, nullptr);
            } else if (k == 2 && EN(2)) {
#ifndef PROBE_SUB
#define PROBE_SUB -1
#endif
#define SUBEN(x) (!P.rep || PROBE_SUB < 0 || PROBE_SUB == (x))
#pragma unroll 1
                for (int slot = 0; slot < 4; ++slot) {
                    const int kind = (slot + (bidx >> 3) + (bidx & 7)) & 3;
                    if (kind == 0) {
#pragma unroll 1
                        for (int u = blockIdx.x; u < 512; u += gridDim.x) { if (ENU(0) && SUBEN(0)) ssd_prep_unit(P, lds, l, u >> 1, u & 1); }
                    } else if (kind == 1) {
#pragma unroll 1
                        for (int v = blockIdx.x; v < 512; v += gridDim.x) { if (ENU(1) && SUBEN(1)) attn_prompt_unit(P, lds, l, v >> 7, (v >> 1) & 63, v & 1); }
                    } else if (kind == 2) {
#pragma unroll 1
                        for (int v = blockIdx.x; v < 256; v += gridDim.x) { if (ENU(2) && SUBEN(2)) ssd_sample_unit(P, lds, l, v >> 1, v & 1); }
                    } else {
#pragma unroll 1
                        for (int v = blockIdx.x; v < 256; v += gridDim.x) { if (ENU(3) && SUBEN(3)) attn_sample_unit(P, lds, l, v >> 1, v & 1); }
                    }
                }
            } else if (k == 3 && EN(3)) phase_scan(P, l);
            else if (k == 4 && EN(4)) {
#pragma unroll 1
                for (int u = blockIdx.x; u < 512; u += gridDim.x) ssd_out_unit(P, lds, l, u >> 1, u & 1); }
            else if (k == 5 && EN(5)) {
                pg8::Gemm g{(const bf16_t*)(P.ws + WS_YCAT), (const bf16_t*)(P.ws + WS_WOUT + l * WOUT_L), MT, DM, DM, P.pad, P.rep == 2}; pg8::SplitOrder S; S.init(DM, DM, 4, gdim, bidx);
                pg8::EpiResid E{xin, XB1, (float*)(P.ws + WS_XSL), l != 0, 1};
                pg8::gemm_phase<pg8::EpiResid, pg8::SplitOrder, false>(lds, g, S, E, nullptr);
            } else if (k == 6 && EN(6)) phase_norm<false>(P, lds, l, XB1, 1, XS, P.in[I_N2] + l * DM, 4);
            else if (k == 7 && EN(7)) {
                pg8::Gemm g{(const bf16_t*)(P.ws + WS_HN), (const bf16_t*)(P.ws + WS_WUP + l * WUP_L), MT, NUP, DM, P.pad, P.rep == 2}; pg8::SplitOrder S; S.init(NUP, DM, 2, gdim, bidx);
                pg8::EpiUp E{(bf16_t*)(P.ws + WS_G), (bf16_t*)(P.ws + WS_UH), P.in[I_FCW] + (size_t)l * 3 * NUP, P.in[I_FCB] + (size_t)l * NUP, (float*)(P.ws + WS_US), P.rep >= 3 ? P.rep - 2 : 0};
                pg8::gemm_phase<pg8::EpiUp, pg8::SplitOrder, false>(lds, g, S, E, nullptr);
            } else if (k == 8 && EN(8)) phase_fixup(P, l);
            else if (k == 9 && EN(9)) {
                pg8::Gemm g{(const bf16_t*)(P.ws + WS_G), (const bf16_t*)(P.ws + WS_WDN + l * WDN_L), MT, DM, DFF, P.pad, P.rep == 2}; pg8::SplitOrder S; S.init(DM, DFF, 11, gdim, bidx);
                pg8::EpiResid E{XB1, l == 0 ? XB2 : (void*)X, (float*)(P.ws + WS_XSL), 1, l == 0};
                pg8::gemm_phase<pg8::EpiResid, pg8::SplitOrder, false>(lds, g, S, E, nullptr);
            }
        }
        if (ph + 1 < P.ph_hi && ph != 0) { if (P.ph_hi > 1000) grid.sync(); xcd_barrier(bar, opaque_tid(P.pad) == 0); }
    }
}

extern "C" void kernel_launch(void* const* d_in, const int* in_sizes, int n_in, void* d_out, int out_size, void* d_ws, size_t ws_size, hipStream_t stream) {
    static int grid = 0;
    if (grid == 0) {
        if (n_in != 24 || ws_size < WS_END) { fprintf(stderr, "kernel_launch: unexpected inputs (n_in %d, ws %zu)\n", n_in, ws_size); grid = -1; return; }
        int dev = 0, cus = 0, per_cu = 0;
        hipGetDevice(&dev); hipDeviceGetAttribute(&cus, hipDeviceAttributeMultiprocessorCount, dev);
        hipFuncSetAttribute((const void*)fwd_megakernel, hipFuncAttributeMaxDynamicSharedMemorySize, LDS_BYTES);
        hipOccupancyMaxActiveBlocksPerMultiprocessor(&per_cu, (const void*)fwd_megakernel, 512, LDS_BYTES);
        (void)hipGetLastError();
        if (per_cu < 1) fprintf(stderr, "kernel_launch: occupancy query says %d blocks/CU\n", per_cu);
        grid = cus > 0 ? cus : 256;
    }
    if (grid < 0) return;
    Params p{};
    for (int i = 0; i < 24; ++i) p.in[i] = (const float*)d_in[i];
    p.out = (float*)d_out; p.ws = (unsigned char*)d_ws;
#if MK_MULTI
    for (int ph = 0; ph < N_PHASES; ++ph) { p.ph_lo = ph; p.ph_hi = ph + 1; p.rep = 0; hipLaunchKernelGGL(fwd_megakernel, dim3(grid), dim3(512), LDS_BYTES, stream, p);
#ifdef PROBE_MASK
#ifndef PROBE_REP
#define PROBE_REP 1
#endif
        if (ph <= 10 && ph != 7 && ((PROBE_MASK >> ph) & 1)) { p.rep = PROBE_REP; for (int r = 0; r < 2; ++r) hipLaunchKernelGGL(fwd_megakernel, dim3(grid), dim3(512), LDS_BYTES, stream, p); }
#endif
    }
#else
    p.ph_lo = 0; p.ph_hi = N_PHASES;
    (void)hipMemsetAsync((char*)d_ws + WS_CTL, 0, 65536, stream);
    void* args[] = {&p};
    hipError_t e = hipLaunchCooperativeKernel((const void*)fwd_megakernel, dim3(grid), dim3(512), args, LDS_BYTES, stream);
    if (e != hipSuccess) fprintf(stderr, "cooperative launch failed: %s (grid %d)\n", hipGetErrorString(e), grid);
#endif
}
```
